# Optimizing an MI355X kernel written in HIP

```python
import math
import jax, jax.numpy as jnp
from jax import lax
import numpy as np

D_MODEL = 1024
BATCH = 4
SEQ = 4096
DEPTH = 1

CHUNK = 64
CONV_W = D_MODEL // 2
CONV_K = 3
N_HEADS = 8
HEAD_DIM = 64
ATT_W = N_HEADS * HEAD_DIM
IDX_HEADS = 4
IDX_DIM = 64
IDX_TOPK = 256
IDX_SCALE = (IDX_HEADS * IDX_DIM) ** -0.5
SPLIT_SIZES = (CONV_W, CONV_W, CONV_W,
               ATT_W, ATT_W, ATT_W,
               IDX_HEADS * IDX_DIM, IDX_DIM, IDX_HEADS,
               D_MODEL, D_MODEL)
IN_W = sum(SPLIT_SIZES)
N_EXPERTS = 32
TOP_K = 4
D_FF = D_MODEL
SWIGLU_LIMIT = 7.0
SWIGLU_ALPHA = 1.702
EXPERT_BLOCK = 256
EPS = 1e-6

kernel_name = 'hybrid_conv_dsa_moe_adaln_block'


def rms_norm(x, g):
    xf = x.astype(jnp.float32)
    y = xf * lax.rsqrt(jnp.mean(xf * xf, axis=-1, keepdims=True) + EPS)
    return (y * g.astype(jnp.float32)).astype(x.dtype)


def causal_depthwise_conv(u, w):
    return lax.conv_general_dilated(
        u, w[:, None, :].astype(u.dtype), window_strides=(1,),
        padding=[(CONV_K - 1, 0)], dimension_numbers=('NWC', 'WIO', 'NWC'),
        feature_group_count=u.shape[-1])


def dsa_sparse_attention(q, k, v, qi, ki, wi):
    bsz, seq = q.shape[0], q.shape[1]
    topk = min(IDX_TOPK, seq // 4)
    nblk = seq // CHUNK
    key_pos = jnp.arange(seq)
    kif = ki.astype(jnp.float32)
    gather = jax.vmap(lambda a, i: a[i])

    def to_blocks(a):
        return jnp.moveaxis(a.reshape(bsz, nblk, CHUNK, *a.shape[2:]), 1, 0)

    def block(args):
        qb, qib, wib, j = args
        limit = (j + 1) * CHUNK
        dots = jnp.einsum('bqhd,bsd->bqhs', qib.astype(jnp.float32), kif)
        score = jnp.einsum('bqh,bqhs->bqs', wib.astype(jnp.float32) * IDX_SCALE, jax.nn.relu(dots))
        score = jnp.where(key_pos[None, None, :] < limit, score, -jnp.inf)
        _, sel = lax.top_k(score, topk)
        valid = sel < limit
        k_sel = gather(k, sel)
        v_sel = gather(v, sel)
        logits = jnp.einsum('bqhd,bqkhd->bqhk', qb, k_sel).astype(jnp.float32) * HEAD_DIM ** -0.5
        logits = jnp.where(valid[:, :, None, :], logits, -jnp.inf)
        p = jax.nn.softmax(logits, axis=-1).astype(v.dtype)
        return jnp.einsum('bqhk,bqkhd->bqhd', p, v_sel)

    out = lax.map(block, (to_blocks(q), to_blocks(qi), to_blocks(wi), jnp.arange(nblk)))
    return jnp.moveaxis(out, 0, 1).reshape(bsz, seq, ATT_W)


def hybrid_mixer(h, w_in, conv_w, q_norm_g, k_norm_g, w_conv_out, w_attn_out, w_o):
    bsz, seq, _ = h.shape
    z = jnp.einsum('bsd,de->bse', h, w_in)
    cuts = list(np.cumsum(SPLIT_SIZES)[:-1])
    xin, gb, gc, q, k, v, qi, ki, wi, g_a, g_b = jnp.split(z, cuts, axis=-1)
    y_a = gb * causal_depthwise_conv(gc * xin, conv_w)
    q = rms_norm(q.reshape(bsz, seq, N_HEADS, HEAD_DIM), q_norm_g)
    k = rms_norm(k.reshape(bsz, seq, N_HEADS, HEAD_DIM), k_norm_g)
    v = v.reshape(bsz, seq, N_HEADS, HEAD_DIM)
    qi = qi.reshape(bsz, seq, IDX_HEADS, IDX_DIM)
    y_b = dsa_sparse_attention(q, k, v, qi, ki, wi)
    merged = (jax.nn.sigmoid(g_a) * jnp.einsum('bsc,cd->bsd', y_a, w_conv_out)
              + jax.nn.sigmoid(g_b) * jnp.einsum('bsc,cd->bsd', y_b, w_attn_out))
    return jnp.einsum('bsd,de->bse', merged, w_o)


def routed_moe(h, w_router, b_router, w_gate_up, b_gate_up, w_down, b_down):
    bsz, seq, d = h.shape
    xt = h.reshape(-1, d)
    n_tok = xt.shape[0]
    logits = (xt @ w_router + b_router).astype(jnp.float32)
    top_val, top_idx = lax.top_k(logits, TOP_K)
    gates = jax.nn.softmax(top_val, axis=-1)
    nk = n_tok * TOP_K
    flat_e = top_idx.reshape(-1)
    flat_tok = jnp.arange(nk) // TOP_K
    flat_g = gates.reshape(-1)
    order = jnp.argsort(flat_e)
    sorted_e = flat_e[order]
    counts = jnp.bincount(flat_e, length=N_EXPERTS)
    padded = (counts + EXPERT_BLOCK - 1) // EXPERT_BLOCK * EXPERT_BLOCK
    pad_end = jnp.cumsum(padded)
    pad_start = pad_end - padded
    start = jnp.cumsum(counts) - counts
    dest = pad_start[sorted_e] + jnp.arange(nk) - start[sorted_e]
    cap = (-(-nk // EXPERT_BLOCK)) * EXPERT_BLOCK + N_EXPERTS * EXPERT_BLOCK
    n_blocks = cap // EXPERT_BLOCK
    buf_tok = jnp.zeros((cap,), jnp.int32).at[dest].set(flat_tok[order].astype(jnp.int32))
    buf_g = jnp.zeros((cap,), jnp.float32).at[dest].set(flat_g[order])
    block_e = jnp.minimum(
        jnp.searchsorted(pad_end, jnp.arange(n_blocks) * EXPERT_BLOCK, side='right'),
        N_EXPERTS - 1)

    def expert_block(args):
        e, tok, g = args
        xb = xt[tok]
        gu = xb @ w_gate_up[e] + b_gate_up[e]
        x_glu = jnp.minimum(gu[:, :D_FF], SWIGLU_LIMIT)
        x_lin = jnp.clip(gu[:, D_FF:], -SWIGLU_LIMIT, SWIGLU_LIMIT)
        act = x_glu * jax.nn.sigmoid(SWIGLU_ALPHA * x_glu) * (x_lin + 1)
        y = act @ w_down[e] + b_down[e]
        return y * g[:, None].astype(y.dtype)

    ys = lax.map(expert_block, (block_e, buf_tok.reshape(n_blocks, EXPERT_BLOCK),
                                buf_g.reshape(n_blocks, EXPERT_BLOCK)))
    out = jnp.zeros_like(xt).at[buf_tok].add(ys.reshape(cap, d).astype(xt.dtype))
    return out.reshape(bsz, seq, d)


def setup_inputs(seed: int = 0) -> dict:
    key = jax.random.key(seed)
    ks = jax.random.split(key, 20)
    f32 = jnp.float32

    def dense(k, shape, fan_in):
        return jax.random.normal(k, shape, f32) * fan_in ** -0.5

    def gain(k, shape):
        return 1.0 + 0.1 * jax.random.normal(k, shape, f32)

    def bias(k, shape, s):
        return s * jax.random.normal(k, shape, f32)

    L = DEPTH
    return {
        'x': jax.random.normal(ks[0], (BATCH, SEQ, D_MODEL), f32),
        'c': jax.random.normal(ks[1], (BATCH, D_MODEL), f32),
        'w_ada': dense(ks[2], (L, D_MODEL, 6 * D_MODEL), D_MODEL),
        'b_ada': bias(ks[3], (L, 6 * D_MODEL), 0.02),
        'norm1_g': gain(ks[4], (L, D_MODEL)),
        'w_in': dense(ks[5], (L, D_MODEL, IN_W), D_MODEL),
        'conv_w': dense(ks[6], (L, CONV_K, CONV_W), CONV_K),
        'q_norm_g': gain(ks[7], (L, HEAD_DIM)),
        'k_norm_g': gain(ks[8], (L, HEAD_DIM)),
        'w_conv_out': dense(ks[9], (L, CONV_W, D_MODEL), CONV_W),
        'w_attn_out': dense(ks[10], (L, ATT_W, D_MODEL), ATT_W),
        'w_o': dense(ks[11], (L, D_MODEL, D_MODEL), D_MODEL),
        'norm2_g': gain(ks[12], (L, D_MODEL)),
        'w_router': dense(ks[13], (L, D_MODEL, N_EXPERTS), D_MODEL),
        'b_router': bias(ks[14], (L, N_EXPERTS), 0.01),
        'w_gate_up': dense(ks[15], (L, N_EXPERTS, D_MODEL, 2 * D_FF), D_MODEL),
        'b_gate_up': bias(ks[16], (L, N_EXPERTS, 2 * D_FF), 0.02),
        'w_down': dense(ks[17], (L, N_EXPERTS, D_FF, D_MODEL), D_FF),
        'b_down': bias(ks[18], (L, N_EXPERTS, D_MODEL), 0.02),
    }


def reference(x, c, w_ada, b_ada, norm1_g, w_in, conv_w, q_norm_g, k_norm_g,
              w_conv_out, w_attn_out, w_o, norm2_g, w_router, b_router,
              w_gate_up, b_gate_up, w_down, b_down):
    for l in range(DEPTH):
        mod = jnp.einsum('bd,de->be', jax.nn.silu(c), w_ada[l]) + b_ada[l]
        sh1, sc1, g1, sh2, sc2, g2 = [m[:, None, :] for m in jnp.split(mod, 6, axis=-1)]
        h = rms_norm(x, norm1_g[l]) * (1 + sc1) + sh1
        x = x + g1 * hybrid_mixer(h, w_in[l], conv_w[l], q_norm_g[l], k_norm_g[l],
                                  w_conv_out[l], w_attn_out[l], w_o[l])
        h = rms_norm(x, norm2_g[l]) * (1 + sc2) + sh2
        x = x + g2 * routed_moe(h, w_router[l], b_router[l], w_gate_up[l], b_gate_up[l],
                                w_down[l], b_down[l])
    return x
```

```cpp
#include <hip/hip_runtime.h>
#include <cstdio>
#include <cstdint>

#ifndef MK_N_LAUNCHES
#define MK_N_LAUNCHES 1
#endif

namespace pg8 {
#define PG8_LAS __attribute__((address_space(3)))
typedef unsigned short bf16_t;
typedef short bf16x8 __attribute__((ext_vector_type(8)));
typedef float f32x4 __attribute__((ext_vector_type(4)));
typedef unsigned u32x4 __attribute__((ext_vector_type(4)));
typedef unsigned u32x2 __attribute__((ext_vector_type(2)));
constexpr int BM = 256, BK = 64, HALF = 128, HTB = HALF * BK * 2, STAGE_BYTES = 8 * HTB, NXCD = 8, WGM = 8;

__host__ __device__ __forceinline__ int lds_byte(int r, int c) { const int st = (r >> 4) * 2 + (c >> 5), rr = r & 15, cc = c & 31, ob = rr * 64 + cc * 2; return st * 1024 + (ob ^ (((ob >> 9) & 1) << 5)); }
__host__ __device__ __forceinline__ void stage_rc(int b, int& R, int& C) { const int st = b / 1024, sb = b % 1024, swz = sb ^ (((sb >> 9) & 1) << 5); R = (st >> 1) * 16 + swz / 64; C = (st & 1) * 32 + (swz % 64) / 2; }
__host__ __device__ __forceinline__ int perm32(int rho) { const int n = rho >> 4, i = rho & 15; return 8 * (i >> 2) + 4 * n + (i & 3); }

struct Unit { int pm, pn; int e, r; };
struct Gemm { const bf16_t* A; const bf16_t* Bt; int M, N, K; };

struct StaticOrder {
    int nM, nN, nwg, G, c;
    __host__ __device__ void init(int M, int N, int G_, int c_) { nM = M / BM; nN = N / BM; nwg = nM * nN; G = G_; c = c_; }
    __host__ __device__ bool next(int i, Unit& u) const {
        const long L = (long)i * G + c; if (L >= nwg) return false;
        int wgid = (int)L; { const int q = nwg / NXCD, r = nwg % NXCD, xcd = wgid % NXCD, off = wgid / NXCD; wgid = (xcd < r ? xcd * (q + 1) : r * (q + 1) + (xcd - r) * q) + off; }
        const int nig = WGM * nN, gid = wgid / nig, fm = gid * WGM, gsz = (nM - fm) < WGM ? (nM - fm) : WGM;
        u.pm = fm + ((wgid % nig) % gsz); u.pn = (wgid % nig) / gsz; u.e = 0; u.r = 0; return true;
    }
    __device__ __forceinline__ const int* rows(const Unit&, int& cnt) const { cnt = 0; return nullptr; }
};

__device__ __forceinline__ unsigned cvt_pk_bf16(float lo, float hi) { unsigned r; asm volatile("v_cvt_pk_bf16_f32 %0, %1, %2" : "=v"(r) : "v"(lo), "v"(hi)); return r; }
__device__ __forceinline__ float bf_lo(unsigned w) { return __uint_as_float(w << 16); }
__device__ __forceinline__ float bf_hi(unsigned w) { return __uint_as_float(w & 0xffff0000u); }
__device__ __forceinline__ float fast_sigmoid(float x) { return __builtin_amdgcn_rcpf(1.0f + __builtin_amdgcn_exp2f(-1.4426950408889634f * x)); }

struct EpiBf16 {
    static constexpr bool PERM = true;
    bf16_t* O; int ldc; const float* bias; int colmod;
    __device__ __forceinline__ void operator()(const f32x4 (&acc)[2][2][4][2], const Unit& u, int wr, int wc, int fr, int fq) const {
        const int row0 = u.pm * BM + wr * 64 + fr; int colt = u.pn * BM; if (colmod) colt %= colmod;
        const int col0 = colt + wc * 32 + 8 * fq, bcol0 = u.pn * BM + wc * 32 + 8 * fq;
        f32x4 bv[2][2];
#pragma unroll
        for (int bj = 0; bj < 2; ++bj)
#pragma unroll
            for (int n = 0; n < 2; ++n) bv[bj][n] = bias ? *(const f32x4*)(bias + bcol0 + bj * HALF + 4 * n) : (f32x4){0.f, 0.f, 0.f, 0.f};
#pragma unroll
        for (int ai = 0; ai < 2; ++ai)
#pragma unroll
            for (int m = 0; m < 4; ++m) { bf16_t* rowp = O + (size_t)(row0 + ai * HALF + m * 16) * ldc + col0;
#pragma unroll
                for (int bj = 0; bj < 2; ++bj) { const f32x4 v0 = acc[ai][bj][m][0] + bv[bj][0], v1 = acc[ai][bj][m][1] + bv[bj][1];
                    u32x4 w; w.x = cvt_pk_bf16(v0[0], v0[1]); w.y = cvt_pk_bf16(v0[2], v0[3]); w.z = cvt_pk_bf16(v1[0], v1[1]); w.w = cvt_pk_bf16(v1[2], v1[3]);
                    *(u32x4*)(rowp + bj * HALF) = w; } }
    }
};

struct EpiMerge {
    static constexpr bool PERM = true;
    bf16_t* MRG; const bf16_t* Z; int zw, gcolA, gcolB;
    __device__ __forceinline__ void operator()(const f32x4 (&acc)[2][2][4][2], const Unit& u, int wr, int wc, int fr, int fq) const {
        const int br = u.pm >= 64 ? 1 : 0, pm = u.pm - 64 * br, pn = u.pn - 4 * br;
        const int row0 = pm * BM + wr * 64 + fr, col0 = pn * BM + wc * 32 + 8 * fq, gcol = br ? gcolB : gcolA;
#pragma unroll
        for (int ai = 0; ai < 2; ++ai)
#pragma unroll
            for (int m = 0; m < 4; ++m) { const size_t row = (size_t)(row0 + ai * HALF + m * 16);
#pragma unroll
                for (int bj = 0; bj < 2; ++bj) {
                    const u32x4 g = *(const u32x4*)(Z + row * zw + gcol + col0 + bj * HALF);
                    bf16_t* op = MRG + row * 1024 + col0 + bj * HALF;
                    f32x4 v0 = acc[ai][bj][m][0], v1 = acc[ai][bj][m][1];
                    v0[0] *= fast_sigmoid(bf_lo(g.x)); v0[1] *= fast_sigmoid(bf_hi(g.x)); v0[2] *= fast_sigmoid(bf_lo(g.y)); v0[3] *= fast_sigmoid(bf_hi(g.y));
                    v1[0] *= fast_sigmoid(bf_lo(g.z)); v1[1] *= fast_sigmoid(bf_hi(g.z)); v1[2] *= fast_sigmoid(bf_lo(g.w)); v1[3] *= fast_sigmoid(bf_hi(g.w));
                    if (br) { const u32x4 p = *(const u32x4*)op;
                        v0[0] += bf_lo(p.x); v0[1] += bf_hi(p.x); v0[2] += bf_lo(p.y); v0[3] += bf_hi(p.y); v1[0] += bf_lo(p.z); v1[1] += bf_hi(p.z); v1[2] += bf_lo(p.w); v1[3] += bf_hi(p.w); }
                    u32x4 w; w.x = cvt_pk_bf16(v0[0], v0[1]); w.y = cvt_pk_bf16(v0[2], v0[3]); w.z = cvt_pk_bf16(v1[0], v1[1]); w.w = cvt_pk_bf16(v1[2], v1[3]);
                    *(u32x4*)op = w; } }
    }
};

struct EpiResid {
    static constexpr bool PERM = false;
    const float* X; float* out; const float* gate;
    __device__ __forceinline__ void operator()(const f32x4 (&acc)[2][2][4][2], const Unit& u, int wr, int wc, int fr, int fq) const {
        const int row0 = u.pm * BM + wr * 64 + fr, col0 = u.pn * BM + wc * 32 + 4 * fq;
        const float* gb = gate + (size_t)((u.pm * BM) >> 12) * 6144;
        f32x4 gv[2][2];
#pragma unroll
        for (int bj = 0; bj < 2; ++bj)
#pragma unroll
            for (int n = 0; n < 2; ++n) gv[bj][n] = *(const f32x4*)(gb + col0 + bj * HALF + n * 16);
#pragma unroll
        for (int ai = 0; ai < 2; ++ai)
#pragma unroll
            for (int m = 0; m < 4; ++m) { const size_t off = (size_t)(row0 + ai * HALF + m * 16) * 1024 + col0;
#pragma unroll
                for (int bj = 0; bj < 2; ++bj)
#pragma unroll
                    for (int n = 0; n < 2; ++n) { const f32x4 xv = *(const f32x4*)(X + off + bj * HALF + n * 16);
                        *(f32x4*)(out + off + bj * HALF + n * 16) = xv + gv[bj][n] * acc[ai][bj][m][n]; } }
    }
};

struct EpiSwiGLU {
    static constexpr bool PERM = true;
    bf16_t* ACT; const float* bgu;
    __device__ __forceinline__ void operator()(const f32x4 (&acc)[2][2][4][2], const Unit& u, int wr, int wc, int fr, int fq) const {
        const int e = u.pn >> 3, cn = u.pn & 7;
        const int row0 = u.pm * BM + wr * 64 + fr, col0 = cn * 128 + wc * 32 + 8 * fq;
        const float* bg = bgu + (size_t)e * 2048 + col0;
        f32x4 bG[2], bL[2];
#pragma unroll
        for (int n = 0; n < 2; ++n) { bG[n] = *(const f32x4*)(bg + 4 * n); bL[n] = *(const f32x4*)(bg + 1024 + 4 * n); }
#pragma unroll
        for (int ai = 0; ai < 2; ++ai)
#pragma unroll
            for (int m = 0; m < 4; ++m) { float o[8];
#pragma unroll
                for (int n = 0; n < 2; ++n)
#pragma unroll
                    for (int j = 0; j < 4; ++j) { const float g = fminf(acc[ai][0][m][n][j] + bG[n][j], 7.0f); float l = acc[ai][1][m][n][j] + bL[n][j]; l = fminf(fmaxf(l, -7.0f), 7.0f);
                        o[4 * n + j] = g * fast_sigmoid(1.702f * g) * (l + 1.0f); }
                u32x4 w; w.x = cvt_pk_bf16(o[0], o[1]); w.y = cvt_pk_bf16(o[2], o[3]); w.z = cvt_pk_bf16(o[4], o[5]); w.w = cvt_pk_bf16(o[6], o[7]);
                *(u32x4*)(ACT + (size_t)(row0 + ai * HALF + m * 16) * 1024 + col0) = w; }
    }
};

template <class Epi, class Sched, bool GATHER = false>
__device__ __forceinline__ void gemm_phase(PG8_LAS unsigned char* lds, const Gemm g, const Sched& S, const Epi& E) {
    int tid_ = threadIdx.x; asm volatile("" : "+v"(tid_));
    const int tid = tid_, wid = __builtin_amdgcn_readfirstlane(tid >> 6), lane = tid & 63, wr = wid >> 2, wc = wid & 3, fr = lane & 15, fq = lane >> 4;
    const int K = g.K, nt = K / BK;
    unsigned voffB[2]; unsigned offA[2][2], offAn[2][2]; int Rr[2], Cc[2];
#pragma unroll
    for (int i = 0; i < 2; ++i) { int R, C; stage_rc(tid * 16 + i * 8192, R, C); const int Rb = Epi::PERM ? ((R & ~31) + perm32(R & 31)) : R; Rr[i] = R; Cc[i] = C;
        voffB[i] = (unsigned)(Rb * K + C) * 2u; }
    const size_t kstep = (size_t)(BK * 2);
    const size_t hstep = (size_t)HALF * K * 2;
    const size_t tstep = 2 * hstep;
    const unsigned ldsw = (unsigned)wid * 1024u;
    const int aoff = lds_byte(wr * 64 + fr, fq * 8), boff = lds_byte(wc * 32 + fr, fq * 8);
#define PG8_SA(b, h) (((b) * 2 + (h)) * HTB)
#define PG8_SB(b, h) ((4 + (b) * 2 + (h)) * HTB)
#define PG8_STAGE(bufoff, gbase, voff) do { _Pragma("unroll") for (int _i = 0; _i < 2; ++_i) \
        __builtin_amdgcn_global_load_lds((const unsigned*)((const char*)(gbase) + (voff)[_i]), (PG8_LAS unsigned*)(lds + (bufoff) + ldsw + _i * 8192), 16, 0, 0); } while (0)
#define PG8_LDA(dst, b, h) do { _Pragma("unroll") for (int m = 0; m < 4; ++m) _Pragma("unroll") for (int k = 0; k < 2; ++k) dst[m][k] = *(const PG8_LAS bf16x8*)(lds + PG8_SA(b, h) + aoff + m * 2048 + k * 1024); } while (0)
#define PG8_LDB(dst, b, h) do { _Pragma("unroll") for (int n = 0; n < 2; ++n) _Pragma("unroll") for (int k = 0; k < 2; ++k) dst[n][k] = *(const PG8_LAS bf16x8*)(lds + PG8_SB(b, h) + boff + n * 2048 + k * 1024); } while (0)
#define PG8_MMA(ai, bj, At, Bt) do { __builtin_amdgcn_s_setprio(1); _Pragma("unroll") for (int m = 0; m < 4; ++m) _Pragma("unroll") for (int n = 0; n < 2; ++n) _Pragma("unroll") for (int k = 0; k < 2; ++k) \
        acc[ai][bj][m][n] = __builtin_amdgcn_mfma_f32_16x16x32_bf16(Bt[n][k], At[m][k], acc[ai][bj][m][n], 0, 0, 0); __builtin_amdgcn_s_setprio(0); } while (0)
#define PG8_WAIT_V(n) asm volatile("s_waitcnt vmcnt(" #n ")" ::: "memory")
#define PG8_WAIT_L(n) asm volatile("s_waitcnt lgkmcnt(" #n ")" ::: "memory")
#define PG8_BAR __builtin_amdgcn_s_barrier()
#define PG8_SCHED __builtin_amdgcn_sched_barrier(0)
#define PG8_AOFFS(dst, U) do { if constexpr (GATHER) { int cnt_; const int* rl_ = S.rows(U, cnt_); \
        _Pragma("unroll") for (int h_ = 0; h_ < 2; ++h_) _Pragma("unroll") for (int i_ = 0; i_ < 2; ++i_) { const int rr_ = (U).r * 256 + h_ * HALF + Rr[i_]; const int tk_ = rr_ < cnt_ ? rl_[rr_] : 0; \
            dst[h_][i_] = (unsigned)tk_ * (unsigned)(K * 2) + (unsigned)(Cc[i_] * 2); } } \
      else { _Pragma("unroll") for (int h_ = 0; h_ < 2; ++h_) _Pragma("unroll") for (int i_ = 0; i_ < 2; ++i_) dst[h_][i_] = (unsigned)((h_ * HALF + Rr[i_]) * K + Cc[i_]) * 2u; } } while (0)
    Unit cur, nxt; int ui = 0;
    if (!S.next(0, cur)) return;
    f32x4 acc[2][2][4][2];
#pragma unroll
    for (int a = 0; a < 2; ++a)
#pragma unroll
        for (int b = 0; b < 2; ++b)
#pragma unroll
            for (int m = 0; m < 4; ++m)
#pragma unroll
                for (int n = 0; n < 2; ++n) acc[a][b][m][n] = (f32x4){0.f, 0.f, 0.f, 0.f};
    bf16x8 At[4][2], B0[2][2], B1[2][2];
    const char* cA = GATHER ? (const char*)g.A : (const char*)g.A + (size_t)cur.pm * tstep; const char* cB = (const char*)g.Bt + (size_t)cur.pn * tstep;
    PG8_AOFFS(offA, cur);
    PG8_STAGE(PG8_SB(0, 0), cB, voffB); PG8_STAGE(PG8_SB(0, 1), cB + hstep, voffB); PG8_STAGE(PG8_SA(0, 0), cA, offA[0]); PG8_STAGE(PG8_SA(0, 1), cA, offA[1]);
    if (wr == 1) PG8_BAR;
    PG8_WAIT_V(2); PG8_BAR;
    PG8_STAGE(PG8_SB(1, 0), cB + kstep, voffB); PG8_STAGE(PG8_SA(1, 0), cA + kstep, offA[0]); PG8_STAGE(PG8_SB(1, 1), cB + hstep + kstep, voffB);
    PG8_WAIT_V(6); PG8_BAR;
    for (;;) {
        const bool has_next = S.next(ui + 1, nxt);
        const char* nA = has_next ? (GATHER ? (const char*)g.A : (const char*)g.A + (size_t)nxt.pm * tstep) : cA; const char* nB = has_next ? (const char*)g.Bt + (size_t)nxt.pn * tstep : cB;
        if constexpr (GATHER) { if (has_next) { PG8_AOFFS(offAn, nxt); } else {
#pragma unroll
            for (int h = 0; h < 2; ++h)
#pragma unroll
                for (int i = 0; i < 2; ++i) offAn[h][i] = offA[h][i]; } }
        else {
#pragma unroll
            for (int h = 0; h < 2; ++h)
#pragma unroll
                for (int i = 0; i < 2; ++i) offAn[h][i] = offA[h][i]; }
        for (int t = 0; t < nt; t += 2) {
            const bool last = (t == nt - 2);
            const char* a1 = cA + (size_t)(t + 1) * kstep;
            const char* a2 = last ? nA : cA + (size_t)(t + 2) * kstep; const char* b2 = last ? nB : cB + (size_t)(t + 2) * kstep;
            const char* a3 = a2 + kstep; const char* b3 = b2 + kstep;
            unsigned o2[2][2];
#pragma unroll
            for (int h = 0; h < 2; ++h)
#pragma unroll
                for (int i = 0; i < 2; ++i) o2[h][i] = (GATHER && last) ? offAn[h][i] : offA[h][i];
            PG8_LDB(B0, 0, 0); PG8_LDB(B1, 0, 1); PG8_SCHED; PG8_LDA(At, 0, 0); PG8_STAGE(PG8_SA(1, 1), a1, offA[1]);
            PG8_WAIT_V(8); PG8_WAIT_L(0); PG8_BAR; PG8_MMA(0, 0, At, B0); PG8_MMA(0, 1, At, B1); PG8_BAR; PG8_SCHED;
            PG8_LDA(At, 0, 1); PG8_STAGE(PG8_SB(0, 0), b2, voffB); PG8_STAGE(PG8_SB(0, 1), b2 + hstep, voffB); PG8_STAGE(PG8_SA(0, 0), a2, o2[0]);
            PG8_WAIT_V(8); PG8_WAIT_L(0); PG8_BAR; PG8_MMA(1, 0, At, B0); PG8_MMA(1, 1, At, B1); PG8_BAR; PG8_SCHED;
            PG8_LDB(B0, 1, 0); PG8_LDB(B1, 1, 1); PG8_SCHED; PG8_LDA(At, 1, 0); PG8_STAGE(PG8_SA(0, 1), a2, o2[1]);
            PG8_WAIT_V(8); PG8_WAIT_L(0); PG8_BAR; PG8_MMA(0, 0, At, B0); PG8_MMA(0, 1, At, B1); PG8_BAR; PG8_SCHED;
            PG8_LDA(At, 1, 1); PG8_STAGE(PG8_SB(1, 0), b3, voffB); PG8_STAGE(PG8_SB(1, 1), b3 + hstep, voffB); PG8_STAGE(PG8_SA(1, 0), a3, o2[0]);
            PG8_WAIT_V(8); PG8_WAIT_L(0); PG8_BAR; PG8_MMA(1, 0, At, B0); PG8_MMA(1, 1, At, B1); PG8_BAR; PG8_SCHED;
        }
        if (wr == 0) PG8_BAR;
        E(acc, cur, wr, wc, fr, fq);
        if (!has_next) break;
#pragma unroll
        for (int a = 0; a < 2; ++a)
#pragma unroll
            for (int b = 0; b < 2; ++b)
#pragma unroll
                for (int m = 0; m < 4; ++m)
#pragma unroll
                    for (int n = 0; n < 2; ++n) acc[a][b][m][n] = (f32x4){0.f, 0.f, 0.f, 0.f};
        cur = nxt; cA = nA; cB = nB; ++ui;
#pragma unroll
        for (int h = 0; h < 2; ++h)
#pragma unroll
            for (int i = 0; i < 2; ++i) offA[h][i] = offAn[h][i];
        if (wr == 1) PG8_BAR;
    }
    PG8_WAIT_V(0);
    PG8_BAR;
#undef PG8_SA
#undef PG8_SB
#undef PG8_STAGE
#undef PG8_LDA
#undef PG8_LDB
#undef PG8_MMA
#undef PG8_WAIT_V
#undef PG8_WAIT_L
#undef PG8_BAR
#undef PG8_SCHED
#undef PG8_AOFFS
}
}
namespace attn_body {
using bf16x8=__attribute__((ext_vector_type(8)))short;
using s16x4=__attribute__((ext_vector_type(4)))short;
using f32x16=__attribute__((ext_vector_type(16)))float;
using u32x4=__attribute__((ext_vector_type(4)))unsigned;
typedef unsigned short bf16;
constexpr int NHEAD=8,SEQ=4096,D=64;
constexpr int PQ=512,PK=512,PO=512;
constexpr int NW=8,QBLK=32,QB=QBLK*NW,KVBLK=64;
__device__ __forceinline__ int crow(int r,int hi){return (r&3)+8*(r>>2)+4*hi;}
#define SBAR() __builtin_amdgcn_sched_barrier(0)
constexpr int NSLOT=3, SLOTB=8192;
constexpr int LDS_K=0, LDS_V=NSLOT*SLOTB, LDS_WS=2*NSLOT*SLOTB, LDS_OST=LDS_WS+NW*64*4, LDS_BYTES=LDS_OST+NW*4096;
__device__ __forceinline__ void glds16(const void*gsrc,unsigned lds_dst){unsigned keep;
  asm volatile("s_mov_b32 %0, m0\n\ts_mov_b32 m0, %2\n\ts_nop 0\n\tglobal_load_lds_dwordx4 %1, off\n\ts_mov_b32 m0, %0":"=&s"(keep):"v"(gsrc),"s"(lds_dst):"memory");}
typedef float f32x2_t __attribute__((ext_vector_type(2))); typedef __bf16 bf16x2_t __attribute__((ext_vector_type(2)));
__device__ __forceinline__ unsigned cvtpk_s(float lo,float hi){f32x2_t v={lo,hi};bf16x2_t b=__builtin_convertvector(v,bf16x2_t);return __builtin_bit_cast(unsigned,b);}
#define WAIT_BAR(N) asm volatile("s_waitcnt vmcnt(" #N ") lgkmcnt(0)\n\ts_barrier":::"memory")
#define WAIT_BAR_M(N,M) asm volatile("s_waitcnt vmcnt(" #N ") lgkmcnt(0)\n\ts_barrier":"+v"(M)::"memory")

__device__ __forceinline__ void qkt(f32x16&p0,f32x16&p1,const char*Kslot,const bf16x8*qr,int r32,int hi){
  const f32x16 negm={};
  const char*kb=Kslot+hi*1024+r32*16;
  #pragma unroll
  for(int d0=0;d0<4;++d0){
    const bf16x8 b0=*reinterpret_cast<const bf16x8*>(kb+d0*2048);
    const bf16x8 b1=*reinterpret_cast<const bf16x8*>(kb+d0*2048+512);
    if(d0==0){p0=__builtin_amdgcn_mfma_f32_32x32x16_bf16(b0,qr[0],negm,0,0,0);p1=__builtin_amdgcn_mfma_f32_32x32x16_bf16(b1,qr[0],negm,0,0,0);}
    else{p0=__builtin_amdgcn_mfma_f32_32x32x16_bf16(b0,qr[d0],p0,0,0,0);p1=__builtin_amdgcn_mfma_f32_32x32x16_bf16(b1,qr[d0],p1,0,0,0);}}
}
typedef __attribute__((address_space(3))) const char* lds_cptr;
typedef short v4i16_t __attribute__((ext_vector_type(4)));
__device__ __forceinline__ void kload8(bf16x8*kf,lds_cptr kp){
  kf[0]=*(const __attribute__((address_space(3))) bf16x8*)(kp);      kf[1]=*(const __attribute__((address_space(3))) bf16x8*)(kp+512);
  kf[2]=*(const __attribute__((address_space(3))) bf16x8*)(kp+2048); kf[3]=*(const __attribute__((address_space(3))) bf16x8*)(kp+2560);
  kf[4]=*(const __attribute__((address_space(3))) bf16x8*)(kp+4096); kf[5]=*(const __attribute__((address_space(3))) bf16x8*)(kp+4608);
  kf[6]=*(const __attribute__((address_space(3))) bf16x8*)(kp+6144); kf[7]=*(const __attribute__((address_space(3))) bf16x8*)(kp+6656);
}
__device__ __forceinline__ void kload2(bf16x8*kf,lds_cptr kp,int j){ kf[2*j]=*(const __attribute__((address_space(3))) bf16x8*)(kp+j*2048); kf[2*j+1]=*(const __attribute__((address_space(3))) bf16x8*)(kp+j*2048+512); }
__device__ __forceinline__ s16x4 vtr(lds_cptr p){ return __builtin_bit_cast(s16x4,__builtin_amdgcn_ds_read_tr16_b64_v4i16((__attribute__((address_space(3))) v4i16_t*)p)); }
__device__ __forceinline__ void pv(f32x16*o,int vb,bf16x8 pa0,bf16x8 pa1,bf16x8 pa2,bf16x8 pa3){
  #pragma unroll
  for(int d0=0;d0<2;++d0){s16x4 lo[4],hi[4];
    #pragma unroll
    for(int ks=0;ks<4;++ks){
      asm volatile("ds_read_b64_tr_b16 %0,%1 offset:%c2":"=&v"(lo[ks]):"v"(vb),"i"(d0*4096+ks*1024):"memory");
      asm volatile("ds_read_b64_tr_b16 %0,%1 offset:%c2":"=&v"(hi[ks]):"v"(vb),"i"(d0*4096+ks*1024+512):"memory");}
    asm volatile("s_waitcnt lgkmcnt(0)":::"memory");SBAR();
    #define PK(k) (bf16x8){lo[k][0],lo[k][1],lo[k][2],lo[k][3],hi[k][0],hi[k][1],hi[k][2],hi[k][3]}
    o[d0]=__builtin_amdgcn_mfma_f32_32x32x16_bf16(pa0,PK(0),o[d0],0,0,0);
    o[d0]=__builtin_amdgcn_mfma_f32_32x32x16_bf16(pa1,PK(1),o[d0],0,0,0);
    o[d0]=__builtin_amdgcn_mfma_f32_32x32x16_bf16(pa2,PK(2),o[d0],0,0,0);
    o[d0]=__builtin_amdgcn_mfma_f32_32x32x16_bf16(pa3,PK(3),o[d0],0,0,0);
    #undef PK
  }
}
#define MBIT(W,r) ((unsigned)__builtin_amdgcn_sbfe((int)(W),(unsigned)(((r)&3)+8*((r)>>2)),1u))
#define MEXP(X,r,W) X[r]=__uint_as_float(__float_as_uint(__builtin_amdgcn_exp2f(X[r]))&MBIT(W,r))
typedef unsigned long long u64;
__device__ __forceinline__ void attn_unit(int b,int h,int qb,const bf16*Q,const bf16*__restrict__ K,const bf16*__restrict__ V,int PV_,bf16*O,const u64*MASK,char*shm){
  int tid_=threadIdx.x; asm volatile("":"+v"(tid_)); const int tid=tid_,lane=tid&63,r32=lane&31,hi=lane>>5; const int wid=__builtin_amdgcn_readfirstlane(tid>>6);
  const long rowbase=(long)b*SEQ; const int q0=qb*QB;
  const bf16*Qw=Q+(rowbase+q0+wid*QBLK)*PQ+h*D;
  const bf16*Kh=K+rowbase*PK+h*D,*Vh=V+rowbase*PV_+h*D;
  const unsigned lds0=(unsigned)(uintptr_t)shm;
  float*wsf=(float*)(shm+LDS_WS)+wid*64;
  const bf16*ksrc=Kh+(long)lane*PK+wid*8;
  const bf16*vsrc=Vh+(long)(16*(wid&3)+(lane>>2))*PV_+(wid>>2)*32+(lane&3)*8;
  const unsigned kdst=lds0+LDS_K+wid*1024, vdst=lds0+LDS_V+wid*1024;
  #define DMA_K(t,slot) glds16(ksrc+(long)(t)*KVBLK*PK,(unsigned)__builtin_amdgcn_readfirstlane(kdst+(slot)))
  #define DMA_V(t,slot) glds16(vsrc+(long)(t)*KVBLK*PV_,(unsigned)__builtin_amdgcn_readfirstlane(vdst+(slot)))
  const u64*mptr=MASK+((long)b*64*SEQ)+(q0+wid*QBLK+r32);
  #define MLOAD(dst,t) dst=mptr[(long)(t)*SEQ]
  const int vb0=(int)(lds0+LDS_V)+((lane>>4)&1)*32+(lane&3)*8+(4*hi+((lane&15)>>2))*64;
  const char*Kbase=shm+LDS_K; bf16x8 kf[8];
  const lds_cptr shm3=(lds_cptr)shm; const lds_cptr kp0=shm3+LDS_K+hi*1024+r32*16; const lds_cptr vp0=shm3+LDS_V+((lane>>4)&1)*32+(lane&3)*8+(4*hi+((lane&15)>>2))*64;
  const int NT=(q0+QB)/KVBLK;
  u64 mA,mB;
  MLOAD(mA,0);
  DMA_K(0,0);DMA_V(0,0);DMA_K(1,SLOTB);
  bf16x8 qr[4];
  #pragma unroll
  for(int d0=0;d0<4;++d0)qr[d0]=*reinterpret_cast<const bf16x8*>(&Qw[(long)r32*PQ+d0*16+hi*8]);
  float l_reg=0.f;f32x16 o[2];o[0]=f32x16{};o[1]=f32x16{};const f32x16 negm={};
  const int msh=4*hi;
  f32x16 pA0,pA1,pB0,pB1;
  int sl_prev=0,sl_cur=0,sl_next=SLOTB;
  #define ROT() do{sl_prev=sl_cur;sl_cur=sl_next;sl_next=(sl_next==(NSLOT-1)*SLOTB)?0:sl_next+SLOTB;}while(0)
  DMA_K(2,2*SLOTB);
  WAIT_BAR(3);
  qkt(pA0,pA1,Kbase,qr,r32,hi);asm volatile("s_nop 15\n\ts_nop 7":"+v"(pA0),"+v"(pA1));
  { const unsigned w0=(unsigned)mA>>msh, w1=(unsigned)(mA>>32)>>msh;
    _Pragma("unroll") for(int r=0;r<16;++r){ MEXP(pA0,r,w0); MEXP(pA1,r,w1); } }
  WAIT_BAR(0);
  MLOAD(mB,1);
  DMA_K(3,0);DMA_V(1,SLOTB);
  ROT();
  kload8(kf,kp0+sl_cur);
  WAIT_BAR(2);
  s16x4 vlo[8],vhi[8]; u32x4 pw0,pw1,pw2,pw3;
  #define PKW(P,B) cvtpk_s(P[B],P[B+1])
  #define PAF(k) __builtin_bit_cast(bf16x8,pw##k)
  #define VFR(i) (bf16x8){vlo[i][0],vlo[i][1],vlo[i][2],vlo[i][3],vhi[i][0],vhi[i][1],vhi[i][2],vhi[i][3]}
  #define PIN(x) asm volatile("":"+v"(x))
  #define GAPA(MF,A0,A1,A2,A3,W0,W1,PW) do{ MF; sacc+=A0; sacc+=A1; sacc+=A2; sacc+=A3; PIN(sacc); W0; W1; PIN(PW); SBAR(); }while(0)
  #define GAPB(MF,X,B,W) do{ MF; MEXP(X,B,W); MEXP(X,B+1,W); MEXP(X,B+2,W); MEXP(X,B+3,W); PIN(X); SBAR(); }while(0)
  #define VRD(i) do{ vlo[i]=vtr(vp_+(((i)>>2)*4096+((i)&3)*1024)); vhi[i]=vtr(vp_+(((i)>>2)*4096+((i)&3)*1024+512)); }while(0)
  #define KRD(G,j) do{ if(G){ kload2(kf,kp0+sl_next,j); SBAR(); } }while(0)
  #define STEP(C0,C1,P0,P1,t,GK,GV,GL,MC,MN,GM) do{ SBAR(); \
    unsigned w0_=(unsigned)(MC)>>msh, w1_=(unsigned)((MC)>>32)>>msh; asm volatile("":"+v"(w0_),"+v"(w1_)); \
    if(GM){MLOAD(MN,(t)+1);} if(GK){DMA_K((t)+3,sl_cur);} if(GV){DMA_V((t)+1,sl_next);} SBAR(); \
    const lds_cptr vp_=vp0+sl_prev; \
    VRD(0); SBAR(); float sacc=(P0[0]+P0[1]); \
    GAPA(C0=__builtin_amdgcn_mfma_f32_32x32x16_bf16(kf[0],qr[0],negm,0,0,0), P0[2],P0[3],P0[4],P0[5],     pw0[0]=PKW(P0,0), pw0[1]=PKW(P0,2), pw0); \
    VRD(4); SBAR(); GAPA(C1=__builtin_amdgcn_mfma_f32_32x32x16_bf16(kf[1],qr[0],negm,0,0,0), P0[6],P0[7],P0[8],P0[9],     pw0[2]=PKW(P0,4), pw0[3]=PKW(P0,6), pw0); \
    VRD(1); SBAR(); GAPA(C0=__builtin_amdgcn_mfma_f32_32x32x16_bf16(kf[2],qr[1],C0,0,0,0),   P0[10],P0[11],P0[12],P0[13], pw1[0]=PKW(P0,8), pw1[1]=PKW(P0,10), pw1); \
    VRD(5); SBAR(); GAPA(C1=__builtin_amdgcn_mfma_f32_32x32x16_bf16(kf[3],qr[1],C1,0,0,0),   P0[14],P0[15],P1[0],P1[1],   pw1[2]=PKW(P0,12),pw1[3]=PKW(P0,14), pw1); \
    VRD(2); SBAR(); GAPA(C0=__builtin_amdgcn_mfma_f32_32x32x16_bf16(kf[4],qr[2],C0,0,0,0),   P1[2],P1[3],P1[4],P1[5],     pw2[0]=PKW(P1,0), pw2[1]=PKW(P1,2), pw2); \
    VRD(6); SBAR(); GAPA(C1=__builtin_amdgcn_mfma_f32_32x32x16_bf16(kf[5],qr[2],C1,0,0,0),   P1[6],P1[7],P1[8],P1[9],     pw2[2]=PKW(P1,4), pw2[3]=PKW(P1,6), pw2); \
    VRD(3); SBAR(); GAPA(C0=__builtin_amdgcn_mfma_f32_32x32x16_bf16(kf[6],qr[3],C0,0,0,0),   P1[10],P1[11],P1[12],P1[13], pw3[0]=PKW(P1,8), pw3[1]=PKW(P1,10), pw3); \
    VRD(7); SBAR(); GAPA(C1=__builtin_amdgcn_mfma_f32_32x32x16_bf16(kf[7],qr[3],C1,0,0,0),   P1[14],P1[15],0.f,0.f,       pw3[2]=PKW(P1,12),pw3[3]=PKW(P1,14), pw3); \
    l_reg+=sacc; \
    SBAR(); \
    GAPB(o[0]=__builtin_amdgcn_mfma_f32_32x32x16_bf16(PAF(0),VFR(0),o[0],0,0,0), C0,0,w0_); \
    GAPB(o[1]=__builtin_amdgcn_mfma_f32_32x32x16_bf16(PAF(0),VFR(4),o[1],0,0,0), C0,4,w0_); \
    KRD(GL,0); GAPB(o[0]=__builtin_amdgcn_mfma_f32_32x32x16_bf16(PAF(1),VFR(1),o[0],0,0,0), C0,8,w0_); \
    KRD(GL,1); GAPB(o[1]=__builtin_amdgcn_mfma_f32_32x32x16_bf16(PAF(1),VFR(5),o[1],0,0,0), C0,12,w0_); \
    KRD(GL,2); GAPB(o[0]=__builtin_amdgcn_mfma_f32_32x32x16_bf16(PAF(2),VFR(2),o[0],0,0,0), C1,0,w1_); \
    KRD(GL,3); GAPB(o[1]=__builtin_amdgcn_mfma_f32_32x32x16_bf16(PAF(2),VFR(6),o[1],0,0,0), C1,4,w1_); \
    GAPB(o[0]=__builtin_amdgcn_mfma_f32_32x32x16_bf16(PAF(3),VFR(3),o[0],0,0,0), C1,8,w1_); \
    GAPB(o[1]=__builtin_amdgcn_mfma_f32_32x32x16_bf16(PAF(3),VFR(7),o[1],0,0,0), C1,12,w1_); \
    }while(0)
  int t=1;
  for(;t+5<NT;t+=2){
    STEP(pB0,pB1,pA0,pA1,t,true,true,true,mB,mA,true);     WAIT_BAR(2); ROT();
    STEP(pA0,pA1,pB0,pB1,t+1,true,true,true,mA,mB,true);   WAIT_BAR(2); ROT();
  }
  #define ENDW(tt,M) do{ if((tt)+3<NT){WAIT_BAR(2);} else if((tt)+2<NT){WAIT_BAR(1);} else {WAIT_BAR(0);} }while(0)
  for(;t+1<NT;t+=2){
    STEP(pB0,pB1,pA0,pA1,t,(t+3<NT),(t+1<NT),(t+1<NT),mB,mA,(t+1<NT));       ENDW(t,mA);   ROT();
    STEP(pA0,pA1,pB0,pB1,t+1,(t+4<NT),(t+2<NT),(t+2<NT),mA,mB,(t+2<NT));     ENDW(t+1,mB); ROT();
  }
  STEP(pB0,pB1,pA0,pA1,NT-1,false,false,false,mB,mA,false);
  { float sacc=pB0[0]+pB0[1]; _Pragma("unroll") for(int r=2;r<16;++r)sacc+=pB0[r]; _Pragma("unroll") for(int r=0;r<16;++r)sacc+=pB1[r]; l_reg+=sacc;
    pw0=(u32x4){PKW(pB0,0),PKW(pB0,2),PKW(pB0,4),PKW(pB0,6)};pw1=(u32x4){PKW(pB0,8),PKW(pB0,10),PKW(pB0,12),PKW(pB0,14)};pw2=(u32x4){PKW(pB1,0),PKW(pB1,2),PKW(pB1,4),PKW(pB1,6)};pw3=(u32x4){PKW(pB1,8),PKW(pB1,10),PKW(pB1,12),PKW(pB1,14)};
    SBAR(); pv(o,vb0+sl_cur,PAF(0),PAF(1),PAF(2),PAF(3)); }
  #undef PKW
  #undef PAF
  #undef VFR
  #undef PIN
  #undef GAPA
  #undef GAPB
  #undef VRD
  #undef KRD
  #undef STEP
  #undef ENDW
  {auto rr=__builtin_amdgcn_permlane32_swap(__float_as_uint(l_reg),__float_as_uint(l_reg),false,false);l_reg=__uint_as_float(rr[0])+__uint_as_float(rr[1]);}
  if(hi==0)wsf[32+r32]=l_reg;asm volatile("s_waitcnt lgkmcnt(0)":::"memory");
  float rli[16];
  #pragma unroll
  for(int r=0;r<16;++r)rli[r]=__builtin_amdgcn_rcpf(wsf[32+crow(r,hi)]);
  bf16*Ow=O+(rowbase+q0+wid*QBLK)*PO+h*D;
  { bf16*stg=(bf16*)(shm+LDS_OST)+wid*2048;
    #pragma unroll
    for(int r=0;r<16;++r){const int orow=crow(r,hi);
      #pragma unroll
      for(int d0=0;d0<2;++d0){ const unsigned pk=cvtpk_s(o[d0][r]*rli[r],0.f); stg[orow*64+d0*32+r32]=(bf16)(pk&0xffffu); } }
    asm volatile("s_waitcnt lgkmcnt(0)":::"memory");
    #pragma unroll
    for(int i=0;i<4;++i){const int row=i*8+(lane>>3),ch=lane&7; const u32x4 v=*(const u32x4*)(stg+row*64+ch*8); *(u32x4*)(Ow+(long)row*PO+ch*8)=v;} }
  asm volatile("s_waitcnt lgkmcnt(0)\n\ts_barrier":::"memory");
  #undef DMA_K
  #undef DMA_V
  #undef MLOAD
  #undef ROT
}
constexpr int ATTN_LDS_BYTES=LDS_BYTES;
#undef SBAR
#undef WAIT_BAR
#undef WAIT_BAR_M
#undef MBIT
#undef MEXP
}
constexpr int NWAVES = 8;
constexpr int N_LAUNCHES = MK_N_LAUNCHES;
constexpr int N_PHASES = 11;

constexpr int DMODEL = 1024, NBATCH = 4, SEQL = 4096, MTOK = NBATCH * SEQL;
constexpr int INW = 5444, ZW = 5632;
constexpr int ZC_XIN = 0, ZC_GB = 512, ZC_GC = 1024, ZC_Q = 1536, ZC_K = 2048, ZC_V = 2560, ZC_GA = 3072, ZC_GBR = 4096, ZC_QI = 5120, ZC_KI = 5376, ZC_WI = 5440;
constexpr int NEXP = 32, DFF = 1024;
constexpr int MAXSLOT = 65536 + NEXP * 256, MAXTILES = MAXSLOT / 256;
constexpr float EPSN = 1e-6f;
constexpr float C2 = 0.125f * 1.4426950408889634f;

constexpr size_t MiB = 1u << 20;
constexpr size_t WS_CTL = 0, CTL_ZERO_BYTES = 1 * MiB;
constexpr size_t WS_WIN = 2 * MiB;
constexpr size_t WS_PAB = 14 * MiB;
constexpr size_t WS_WO = 16 * MiB;
constexpr size_t WS_WGU = 18 * MiB;
constexpr size_t WS_WD = 146 * MiB;
constexpr size_t WS_H = 210 * MiB;
constexpr size_t WS_Z = 242 * MiB;
constexpr size_t WS_ACT = WS_Z;
constexpr size_t WS_QN = 418 * MiB, WS_KN = 434 * MiB;
constexpr size_t WS_YAB = 450 * MiB;
constexpr size_t WS_MASK = 482 * MiB;
constexpr size_t WS_MRG = 490 * MiB;
constexpr size_t WS_YBUF = 522 * MiB;
constexpr size_t WS_LIST = 666 * MiB;
constexpr size_t WS_TOKER = 668 * MiB;
constexpr size_t WS_TOKG = 669 * MiB;
constexpr size_t WS_END = 670 * MiB;
constexpr int CW_BAR = 4096;
constexpr int CW_ECNT = 8192;
constexpr int CW_MOD = 16384;

constexpr int RING_OFF = 0, RING_BYTES = 131072;
constexpr int LDSCTL_OFF = RING_BYTES, MISC_OFF = LDSCTL_OFF + 320, TAB_OFF = LDSCTL_OFF + 1024;
constexpr int LDS_BYTES = 147456;

#define GAS __attribute__((address_space(1)))
#define LAS __attribute__((address_space(3)))
typedef unsigned short bf16;
typedef unsigned v4u __attribute__((ext_vector_type(4)));
typedef float f32x4 __attribute__((ext_vector_type(4)));
typedef float f32x2 __attribute__((ext_vector_type(2)));
typedef float f32x16 __attribute__((ext_vector_type(16)));
typedef short bf16x8 __attribute__((ext_vector_type(8)));
typedef unsigned long long u64;
#define RLX_AGENT __ATOMIC_RELAXED, __HIP_MEMORY_SCOPE_AGENT
#define LDS_WAIT() asm volatile("s_waitcnt lgkmcnt(0)" ::: "memory")
#define VM_WAIT() asm volatile("s_waitcnt vmcnt(0)" ::: "memory")
__device__ __forceinline__ unsigned pkbf(float lo, float hi) { return pg8::cvt_pk_bf16(lo, hi); }
__device__ __forceinline__ float bflo(unsigned w) { return __uint_as_float(w << 16); }
__device__ __forceinline__ float bfhi(unsigned w) { return __uint_as_float(w & 0xffff0000u); }
__device__ __forceinline__ float bf2f(bf16 h) { return __uint_as_float((unsigned)h << 16); }
__device__ __forceinline__ float wave_sum(float v) {
#pragma unroll
    for (int o = 1; o < 64; o <<= 1) v += __shfl_xor(v, o);
    return v;
}
__device__ __forceinline__ float wave_max(float v) {
#pragma unroll
    for (int o = 1; o < 64; o <<= 1) v = fmaxf(v, __shfl_xor(v, o));
    return v;
}

#define XB_TMO      128
#define XB_XCNT(j)  (256  + 64 * (j))
#define XB_XSUB(j)  (1280 + 64 * (j))
#define XB_XGEN(j)  (2304 + 64 * (j))
#define XB_TOP      3328
#define XB_TOPGEN   3392
#define XCD_BAR_WORDS 3456
#define XB_SPIN_CAP (1u << 18)
__device__ __forceinline__ unsigned xb_ld(unsigned* p)              { return __hip_atomic_load(p, __ATOMIC_RELAXED, __HIP_MEMORY_SCOPE_AGENT); }
__device__ __forceinline__ unsigned xb_add(unsigned* p, unsigned v) { return __hip_atomic_fetch_add(p, v, __ATOMIC_RELAXED, __HIP_MEMORY_SCOPE_AGENT); }
__device__ __forceinline__ unsigned xb_xcc_id() { return (unsigned)__builtin_amdgcn_s_getreg((3 << 11) | 20) & 0xFu; }
#define XB_SPIN(cond, bar) do { unsigned _sp = 0; while (cond) { __builtin_amdgcn_s_sleep(1); \
    if ((++_sp & 255u) == 0u) { if (xb_ld(&(bar)[XB_TMO])) break; if (_sp > XB_SPIN_CAP) { atomicAdd(&(bar)[XB_TMO], 1u); break; } } } } while (0)
struct XcdBarrier { unsigned* bar; unsigned x; volatile LAS unsigned* st; };
__device__ __forceinline__ XcdBarrier xcd_barrier_post(unsigned* bar, volatile LAS unsigned* st) {
    XcdBarrier b; b.bar = bar; b.x = xb_xcc_id(); b.st = st;
    if (threadIdx.x == 0) (void)xb_add(&bar[XB_XCNT(b.x)], 1u);
    return b;
}
__device__ __forceinline__ void xcd_barrier_complete(unsigned* bar, unsigned x, unsigned& nloc, unsigned& nx) {
    const unsigned G = gridDim.x * gridDim.y * gridDim.z;
    unsigned sum, cnt, mine, sp = 0u;
    for (;;) {
        sum = 0u; cnt = 0u; mine = 0u;
#pragma unroll
        for (unsigned j = 0; j < 16; ++j) { const unsigned c = xb_ld(&bar[XB_XCNT(j)]); sum += c; cnt += (c > 0u) ? 1u : 0u; mine = (j == x) ? c : mine; }
        if (sum == G) break;
        __builtin_amdgcn_s_sleep(1);
        if ((++sp & 255u) == 0u) { if (xb_ld(&bar[XB_TMO])) break; if (sp > XB_SPIN_CAP) { atomicAdd(&bar[XB_TMO], 1u); break; } }
    }
    nloc = mine > 0u ? mine : 1u; nx = cnt > 0u ? cnt : 1u;
}
__device__ __forceinline__ void xcd_barrier(const XcdBarrier& b) {
    asm volatile("s_waitcnt vmcnt(0)" ::: "memory");
    __syncthreads();
    if (threadIdx.x == 0) {
        unsigned* bar = b.bar;
        __builtin_amdgcn_s_waitcnt(0);
        unsigned nloc = b.st[0], nx = b.st[1];
        if (nloc == 0u) { xcd_barrier_complete(bar, b.x, nloc, nx); b.st[0] = nloc; b.st[1] = nx; }
        const unsigned old = xb_add(&bar[XB_XSUB(b.x)], 1u);
        const unsigned gen = old / nloc;
        if (old + 1u == (gen + 1u) * nloc) {
            __builtin_amdgcn_fence(__ATOMIC_RELEASE, "agent");
            asm volatile("s_waitcnt vmcnt(0)" ::: "memory");
            const unsigned og = xb_add(&bar[XB_TOP], 1u);
            const unsigned tg = og / nx;
            if (og + 1u == (tg + 1u) * nx) xb_add(&bar[XB_TOPGEN], 1u);
            else XB_SPIN(xb_ld(&bar[XB_TOPGEN]) == tg, bar);
            __builtin_amdgcn_fence(__ATOMIC_ACQUIRE, "agent");
            xb_add(&bar[XB_XGEN(b.x)], 1u);
            asm volatile("s_waitcnt vmcnt(0)" ::: "memory");
        } else {
            XB_SPIN(xb_ld(&bar[XB_XGEN(b.x)]) == gen, bar);
            __builtin_amdgcn_fence(__ATOMIC_ACQUIRE, "agent");
            asm volatile("s_waitcnt vmcnt(0)" ::: "memory");
        }
    }
    __syncthreads();
}

struct Args { const float* in[19]; float* out; unsigned char* ws; int ph_lo, ph_hi; };
typedef const __attribute__((address_space(4))) Args* kargs_t;
typedef const float* cfptr_t; typedef const __attribute__((address_space(4))) cfptr_t* inarr_t;
__device__ __forceinline__ kargs_t kargs() {
#if defined(__HIP_DEVICE_COMPILE__)
    unsigned long long v = (unsigned long long)__builtin_amdgcn_kernarg_segment_ptr(); asm volatile("" : "+s"(v)); return (kargs_t)v;
#else
    return (kargs_t)0;
#endif
}
struct Frame {
    LAS unsigned char* lds;
    volatile LAS unsigned* MISC;
    int tid, lane, wave, vcu, G, bx;
};
enum { I_X = 0, I_C, I_WADA, I_BADA, I_N1G, I_WIN, I_CONVW, I_QNG, I_KNG, I_WCO, I_WAO, I_WO, I_N2G, I_WR, I_BR, I_WGU, I_BGU, I_WD, I_BD };

__device__ __forceinline__ void ph_adaln(Frame& F) {
    { int t_ = threadIdx.x; asm volatile("" : "+v"(t_)); F.tid = t_; F.lane = t_ & 63; F.wave = __builtin_amdgcn_readfirstlane(t_ >> 6); }
    kargs_t ap = kargs(); inarr_t IN = (inarr_t)ap->in; unsigned char* WS = ap->ws; unsigned* CTL = (unsigned*)(WS + WS_CTL); float* OUT = ap->out; (void)IN; (void)OUT; (void)CTL;
    float* mod = (float*)(CTL + CW_MOD);
    const float* c = IN[I_C]; const float* W = IN[I_WADA]; const float* ba = IN[I_BADA];
    const int gw = F.vcu * NWAVES + F.wave, NGW = F.G * NWAVES;
    for (int it = gw; it < 1536; it += NGW) {
        const int c0 = 4 * it;
        f32x4 acc[4];
#pragma unroll
        for (int b = 0; b < 4; ++b) acc[b] = (f32x4){0.f, 0.f, 0.f, 0.f};
#pragma unroll 4
        for (int i = 0; i < 16; ++i) {
            const int k = 64 * i + F.lane;
            const f32x4 w = *(const f32x4*)(W + (size_t)k * 6144 + c0);
#pragma unroll
            for (int b = 0; b < 4; ++b) { const float cv = c[b * 1024 + k]; const float s = cv * pg8::fast_sigmoid(cv); acc[b] += w * s; }
        }
#pragma unroll
        for (int b = 0; b < 4; ++b) {
            const float a0 = wave_sum(acc[b].x), a1 = wave_sum(acc[b].y), a2 = wave_sum(acc[b].z), a3 = wave_sum(acc[b].w);
            if (F.lane == 0) *(f32x4*)(mod + b * 6144 + c0) = (f32x4){a0 + ba[c0], a1 + ba[c0 + 1], a2 + ba[c0 + 2], a3 + ba[c0 + 3]};
        }
    }
}

__device__ __forceinline__ void tr_item(const float* src, int ldw, int nvalid, bf16* dst, int K, int lane) {
    const int kc = lane >> 3, ng = lane & 7;
    f32x4 v[8];
    const bool ok = 4 * ng < nvalid;
#pragma unroll
    for (int i = 0; i < 8; ++i) v[i] = ok ? *(const f32x4*)(src + (size_t)(8 * kc + i) * ldw + 4 * ng) : (f32x4){0.f, 0.f, 0.f, 0.f};
#pragma unroll
    for (int j = 0; j < 4; ++j) {
        v4u o; o.x = pkbf(v[0][j], v[1][j]); o.y = pkbf(v[2][j], v[3][j]); o.z = pkbf(v[4][j], v[5][j]); o.w = pkbf(v[6][j], v[7][j]);
        *(v4u*)(dst + (size_t)(4 * ng + j) * K + 8 * kc) = o;
    }
}
__device__ __forceinline__ void norm_row_to_bf16(const float* xrow, const float* g, const float* sc, const float* sh, bf16* orow, int lane) {
    const f32x4* xr = (const f32x4*)xrow + lane;
    f32x4 v[4]; float s = 0.f;
#pragma unroll
    for (int j = 0; j < 4; ++j) { v[j] = xr[64 * j]; s += (v[j].x * v[j].x + v[j].y * v[j].y) + (v[j].z * v[j].z + v[j].w * v[j].w); }
    const float rstd = 1.0f / sqrtf(wave_sum(s) * (1.f / 1024.f) + EPSN);
    u64* o8 = (u64*)orow + lane;
#pragma unroll
    for (int j = 0; j < 4; ++j) {
        const f32x4 gv = ((const f32x4*)g)[lane + 64 * j], scv = ((const f32x4*)sc)[lane + 64 * j], shv = ((const f32x4*)sh)[lane + 64 * j];
        const f32x4 y = (v[j] * rstd) * gv * (scv + 1.0f) + shv;
        o8[64 * j] = (u64)pkbf(y.x, y.y) | ((u64)pkbf(y.z, y.w) << 32);
    }
}
__device__ __forceinline__ void ph_prologue(Frame& F) {
    { int t_ = threadIdx.x; asm volatile("" : "+v"(t_)); F.tid = t_; F.lane = t_ & 63; F.wave = __builtin_amdgcn_readfirstlane(t_ >> 6); }
    kargs_t ap = kargs(); inarr_t IN = (inarr_t)ap->in; unsigned char* WS = ap->ws; unsigned* CTL = (unsigned*)(WS + WS_CTL); float* OUT = ap->out; (void)IN; (void)OUT; (void)CTL;
    const int gw = F.vcu * NWAVES + F.wave, NGW = F.G * NWAVES;
    bf16* Win_t = (bf16*)(WS + WS_WIN); bf16* Pab_t = (bf16*)(WS + WS_PAB); bf16* Wo_t = (bf16*)(WS + WS_WO); bf16* Wgu_t = (bf16*)(WS + WS_WGU); bf16* Wd_t = (bf16*)(WS + WS_WD);
    constexpr int I_IN = 16 * 176, I_PA = 8 * 32, I_PB = 8 * 32, I_O = 16 * 32, I_GU = 32 * 16 * 64, I_D = 32 * 16 * 32;
    constexpr int NITEMS = I_IN + I_PA + I_PB + I_O + I_GU + I_D;
    for (int it = gw; it < NITEMS; it += NGW) {
        int r = it;
        if (r < I_IN) { const int kb = r / 176, nb = r % 176, n0 = 32 * nb; int c0, nv;
            if (n0 < 3072) { c0 = n0; nv = 32; } else if (n0 < 5120) { c0 = n0 + 324; nv = 32; } else if (n0 < 5440) { c0 = n0 - 2048; nv = 32; } else if (n0 == 5440) { c0 = 3392; nv = 4; } else { c0 = 0; nv = 0; }
            tr_item(IN[I_WIN] + (size_t)(64 * kb) * INW + c0, INW, nv, Win_t + (size_t)n0 * 1024 + 64 * kb, 1024, F.lane); continue; } r -= I_IN;
        if (r < I_PA) { const int kb = r / 32, nb = r % 32; tr_item(IN[I_WCO] + (size_t)(64 * kb) * 1024 + 32 * nb, 1024, 32, Pab_t + (size_t)(32 * nb) * 512 + 64 * kb, 512, F.lane); continue; } r -= I_PA;
        if (r < I_PB) { const int kb = r / 32, nb = r % 32; tr_item(IN[I_WAO] + (size_t)(64 * kb) * 1024 + 32 * nb, 1024, 32, Pab_t + (size_t)(1024 + 32 * nb) * 512 + 64 * kb, 512, F.lane); continue; } r -= I_PB;
        if (r < I_O) { const int kb = r / 32, nb = r % 32; tr_item(IN[I_WO] + (size_t)(64 * kb) * 1024 + 32 * nb, 1024, 32, Wo_t + (size_t)(32 * nb) * 1024 + 64 * kb, 1024, F.lane); continue; } r -= I_O;
        if (r < I_GU) { const int e = r / 1024, q = r % 1024, kb = q / 64, nb = q % 64; const int cn = nb >> 3, bj = (nb >> 2) & 1, sub = nb & 3, c0 = 1024 * bj + 128 * cn + 32 * sub;
            tr_item(IN[I_WGU] + ((size_t)e * 1024 + 64 * kb) * 2048 + c0, 2048, 32, Wgu_t + ((size_t)e * 2048 + 32 * nb) * 1024 + 64 * kb, 1024, F.lane); continue; } r -= I_GU;
        { const int e = r / 512, q = r % 512, kb = q / 32, nb = q % 32;
            tr_item(IN[I_WD] + ((size_t)e * 1024 + 64 * kb) * 1024 + 32 * nb, 1024, 32, Wd_t + ((size_t)e * 1024 + 32 * nb) * 1024 + 64 * kb, 1024, F.lane); }
    }
    const float* mod = (const float*)(CTL + CW_MOD);
    bf16* H = (bf16*)(WS + WS_H);
    for (int m = gw; m < MTOK; m += NGW) { const float* mb = mod + (size_t)(m >> 12) * 6144;
        norm_row_to_bf16(IN[I_X] + (size_t)m * 1024, IN[I_N1G], mb + 1024, mb, H + (size_t)m * 1024, F.lane); }
}

__device__ __forceinline__ void sel_unit(Frame& F, int b, int j, int hf) {
    { int t_ = threadIdx.x; asm volatile("" : "+v"(t_)); F.tid = t_; F.lane = t_ & 63; F.wave = __builtin_amdgcn_readfirstlane(t_ >> 6); }
    kargs_t ap = kargs(); inarr_t IN = (inarr_t)ap->in; unsigned char* WS = ap->ws; unsigned* CTL = (unsigned*)(WS + WS_CTL); float* OUT = ap->out; (void)IN; (void)OUT; (void)CTL;
    LAS unsigned* hist = (LAS unsigned*)(F.lds);
    LAS unsigned* mgt = (LAS unsigned*)(F.lds + 32768);
    LAS unsigned* meq = (LAS unsigned*)(F.lds + 49152);
    LAS unsigned* part = (LAS unsigned*)(F.lds + 65536);
    LAS unsigned* st = (LAS unsigned*)(F.lds + 67584);
    const int tid = F.tid, lane = F.lane, wid = F.wave, r = lane & 31, hi = lane >> 5;
    const int N = 64 * (j + 1), nkt = N / 32, tmax = 4 * (j / 4) + 3;
    const bf16* Z = (const bf16*)(WS + WS_Z);
    u64* mout = (u64*)(WS + WS_MASK) + (size_t)b * 64 * SEQL + (64 * j + 32 * hf);
    if (N <= 256) {
        for (int idx = tid; idx < (tmax + 1) * 32; idx += 512) { const int tile = idx >> 5, q = idx & 31; mout[(size_t)tile * SEQL + q] = tile <= j ? ~0ull : 0ull; }
        return;
    }
    for (int i = tid; i < 16384; i += 512) hist[i] = 0u;
    if (tid < 32) { st[tid] = 0u; st[32 + tid] = 256u; st[64 + tid] = 0u; }
    const bf16* qrow = Z + (size_t)(b * SEQL + 64 * j + 32 * hf + r) * ZW;
    bf16x8 qf[4][4]; float wq[4];
#pragma unroll
    for (int h = 0; h < 4; ++h) {
#pragma unroll
        for (int ks = 0; ks < 4; ++ks) qf[h][ks] = *(const bf16x8*)(qrow + ZC_QI + 64 * h + 16 * ks + 8 * hi);
        wq[h] = bf2f(qrow[ZC_WI + h]) * 0.0625f;
    }
    const bf16* kbase = Z + (size_t)(b * SEQL + r) * ZW + ZC_KI + 8 * hi;
    __syncthreads();
    for (int pass = 0; pass < 5; ++pass) {
        const int shift = 24 - 8 * pass;
        const unsigned prefix = st[r];
        const unsigned himask = pass == 0 ? 0u : (pass >= 4 ? 0xffffffffu : (0xffffffffu << (shift + 8)));
        for (int kt = wid; kt < nkt; kt += 8) {
            const bf16* kp = kbase + (size_t)(32 * kt) * ZW;
            bf16x8 kf[4];
#pragma unroll
            for (int ks = 0; ks < 4; ++ks) kf[ks] = *(const bf16x8*)(kp + 16 * ks);
            float sc[16];
#pragma unroll
            for (int h = 0; h < 4; ++h) {
                f32x16 acc = {};
#pragma unroll
                for (int ks = 0; ks < 4; ++ks) acc = __builtin_amdgcn_mfma_f32_32x32x16_bf16(kf[ks], qf[h][ks], acc, 0, 0, 0);
#pragma unroll
                for (int g = 0; g < 16; ++g) { const float rl = fmaxf(acc[g], 0.f); sc[g] = h == 0 ? wq[0] * rl : fmaf(wq[h], rl, sc[g]); }
            }
            if (pass < 4) {
#pragma unroll
                for (int g = 0; g < 16; ++g) { unsigned u = __float_as_uint(sc[g]); u = (u == 0x80000000u) ? 0u : u; const unsigned key = u ^ ((unsigned)((int)u >> 31) | 0x80000000u);
                    if (((key ^ prefix) & himask) == 0u) __hip_atomic_fetch_add(hist + ((key >> shift) & 255u) * 32 + r, 1u, __ATOMIC_RELAXED, __HIP_MEMORY_SCOPE_WORKGROUP); }
            } else {
                unsigned bg = 0u, be = 0u;
#pragma unroll
                for (int g = 0; g < 16; ++g) { unsigned u = __float_as_uint(sc[g]); u = (u == 0x80000000u) ? 0u : u; const unsigned key = u ^ ((unsigned)((int)u >> 31) | 0x80000000u);
                    const unsigned pos = (unsigned)((g & 3) + 8 * (g >> 2));
                    bg |= (key > prefix ? 1u : 0u) << pos; be |= (key == prefix ? 1u : 0u) << pos; }
                bg <<= 4 * hi; be <<= 4 * hi;
                __hip_atomic_fetch_or(mgt + kt * 32 + r, bg, __ATOMIC_RELAXED, __HIP_MEMORY_SCOPE_WORKGROUP);
                __hip_atomic_fetch_or(meq + kt * 32 + r, be, __ATOMIC_RELAXED, __HIP_MEMORY_SCOPE_WORKGROUP);
            }
        }
        __syncthreads();
        if (pass < 4) {
            const int q = tid & 31, g = tid >> 5;
            unsigned c[16], sum = 0u;
#pragma unroll
            for (int i = 0; i < 16; ++i) { c[i] = hist[(16 * g + i) * 32 + q]; sum += c[i]; hist[(16 * g + i) * 32 + q] = 0u; }
            part[g * 32 + q] = sum;
            const unsigned kr = st[32 + q];
            __syncthreads();
            unsigned above = 0u;
            for (int gg = g + 1; gg < 16; ++gg) above += part[gg * 32 + q];
            if (above < kr && kr <= above + sum) {
                unsigned cum = above; int dig = 16 * g; unsigned ce = 0u;
#pragma unroll
                for (int i = 15; i >= 0; --i) { if (cum < kr && kr <= cum + c[i]) { dig = 16 * g + i; ce = c[i]; st[32 + q] = kr - cum; } cum += c[i]; }
                st[q] |= (unsigned)dig << shift; st[64 + q] = ce;
            }
            __syncthreads();
        }
    }
    {
        const int q = tid & 31, g = tid >> 5;
        const unsigned need = st[32 + q], ce = st[64 + q];
        if (ce > need) {
            if (g == 0) { unsigned taken = 0u;
                for (int kt = 0; kt < nkt; ++kt) { unsigned w = meq[kt * 32 + q]; const unsigned cnt = __popc(w);
                    if (taken + cnt > need) { unsigned keep = 0u; unsigned left = need - taken; while (left) { const unsigned lb = w & (0u - w); keep |= lb; w ^= lb; --left; } w = keep; taken = need; } else taken += cnt;
                    mgt[kt * 32 + q] |= w; } }
        } else {
            for (int kt = g; kt < nkt; kt += 16) mgt[kt * 32 + q] |= meq[kt * 32 + q];
        }
        __syncthreads();
        for (int tile = g; tile <= tmax; tile += 16) {
            const unsigned lo = 2 * tile < nkt ? mgt[(2 * tile) * 32 + q] : 0u, hw = 2 * tile + 1 < nkt ? mgt[(2 * tile + 1) * 32 + q] : 0u;
            mout[(size_t)tile * SEQL + q] = (u64)lo | ((u64)hw << 32);
        }
        __syncthreads();
    }
}
__device__ __forceinline__ void ph_select(Frame& F) {
    { int t_ = threadIdx.x; asm volatile("" : "+v"(t_)); F.tid = t_; F.lane = t_ & 63; F.wave = __builtin_amdgcn_readfirstlane(t_ >> 6); }
    kargs_t ap = kargs(); inarr_t IN = (inarr_t)ap->in; unsigned char* WS = ap->ws; unsigned* CTL = (unsigned*)(WS + WS_CTL); float* OUT = ap->out; (void)IN; (void)OUT; (void)CTL;
    {
        const bf16* Z = (const bf16*)(WS + WS_Z);
        bf16* Qn = (bf16*)(WS + WS_QN); bf16* Kn = (bf16*)(WS + WS_KN); bf16* YA = (bf16*)(WS + WS_YAB);
        const int lane = F.lane, d0 = (8 * lane) & 63, c0 = 8 * lane;
        float gq[8], gk[8], w0[8], w1[8], w2[8];
#pragma unroll
        for (int i = 0; i < 8; ++i) { gq[i] = IN[I_QNG][d0 + i] * C2; gk[i] = IN[I_KNG][d0 + i]; w0[i] = IN[I_CONVW][c0 + i]; w1[i] = IN[I_CONVW][512 + c0 + i]; w2[i] = IN[I_CONVW][1024 + c0 + i]; }
        for (int tb = F.vcu; tb < MTOK / 64; tb += F.G) {
            const int tok0 = tb * 64 + 8 * F.wave;
            float um2[8], um1[8];
#pragma unroll
            for (int k = 0; k < 2; ++k) { const int tk = tok0 - 2 + k; float* dst = k == 0 ? um2 : um1;
                if ((tok0 & (SEQL - 1)) >= 2 - k) { const bf16* zr = Z + (size_t)tk * ZW; const v4u xi = *(const v4u*)(zr + ZC_XIN + c0), gc = *(const v4u*)(zr + ZC_GC + c0);
                    dst[0] = bflo(xi.x) * bflo(gc.x); dst[1] = bfhi(xi.x) * bfhi(gc.x); dst[2] = bflo(xi.y) * bflo(gc.y); dst[3] = bfhi(xi.y) * bfhi(gc.y);
                    dst[4] = bflo(xi.z) * bflo(gc.z); dst[5] = bfhi(xi.z) * bfhi(gc.z); dst[6] = bflo(xi.w) * bflo(gc.w); dst[7] = bfhi(xi.w) * bfhi(gc.w); }
                else {
#pragma unroll
                    for (int i = 0; i < 8; ++i) dst[i] = 0.f; } }
            for (int i = 0; i < 8; ++i) {
                const int tok = tok0 + i; const bf16* zr = Z + (size_t)tok * ZW;
                const v4u xi = *(const v4u*)(zr + ZC_XIN + c0), gc = *(const v4u*)(zr + ZC_GC + c0), gb = *(const v4u*)(zr + ZC_GB + c0), qv = *(const v4u*)(zr + ZC_Q + c0), kv = *(const v4u*)(zr + ZC_K + c0);
                float u[8] = {bflo(xi.x) * bflo(gc.x), bfhi(xi.x) * bfhi(gc.x), bflo(xi.y) * bflo(gc.y), bfhi(xi.y) * bfhi(gc.y), bflo(xi.z) * bflo(gc.z), bfhi(xi.z) * bfhi(gc.z), bflo(xi.w) * bflo(gc.w), bfhi(xi.w) * bfhi(gc.w)};
                const float gbf[8] = {bflo(gb.x), bfhi(gb.x), bflo(gb.y), bfhi(gb.y), bflo(gb.z), bfhi(gb.z), bflo(gb.w), bfhi(gb.w)};
                float y[8];
#pragma unroll
                for (int k = 0; k < 8; ++k) { y[k] = gbf[k] * (w0[k] * um2[k] + w1[k] * um1[k] + w2[k] * u[k]); um2[k] = um1[k]; um1[k] = u[k]; }
                if ((tok & (SEQL - 1)) == 0) {
                }
                *(v4u*)(YA + (size_t)tok * 512 + c0) = (v4u){pkbf(y[0], y[1]), pkbf(y[2], y[3]), pkbf(y[4], y[5]), pkbf(y[6], y[7])};
                float qf_[8] = {bflo(qv.x), bfhi(qv.x), bflo(qv.y), bfhi(qv.y), bflo(qv.z), bfhi(qv.z), bflo(qv.w), bfhi(qv.w)};
                float kf_[8] = {bflo(kv.x), bfhi(kv.x), bflo(kv.y), bfhi(kv.y), bflo(kv.z), bfhi(kv.z), bflo(kv.w), bfhi(kv.w)};
                float sq = 0.f, sk = 0.f;
#pragma unroll
                for (int k = 0; k < 8; ++k) { sq += qf_[k] * qf_[k]; sk += kf_[k] * kf_[k]; }
                sq += __shfl_xor(sq, 1); sk += __shfl_xor(sk, 1); sq += __shfl_xor(sq, 2); sk += __shfl_xor(sk, 2); sq += __shfl_xor(sq, 4); sk += __shfl_xor(sk, 4);
                const float rq = 1.0f / sqrtf(sq * (1.f / 64.f) + EPSN), rk = 1.0f / sqrtf(sk * (1.f / 64.f) + EPSN);
#pragma unroll
                for (int k = 0; k < 8; ++k) { qf_[k] = qf_[k] * rq * gq[k]; kf_[k] = kf_[k] * rk * gk[k]; }
                *(v4u*)(Qn + (size_t)tok * 512 + c0) = (v4u){pkbf(qf_[0], qf_[1]), pkbf(qf_[2], qf_[3]), pkbf(qf_[4], qf_[5]), pkbf(qf_[6], qf_[7])};
                *(v4u*)(Kn + (size_t)tok * 512 + c0) = (v4u){pkbf(kf_[0], kf_[1]), pkbf(kf_[2], kf_[3]), pkbf(kf_[4], kf_[5]), pkbf(kf_[6], kf_[7])};
            }
        }
    }
    for (int v = F.vcu; v < 256; v += F.G) {
        const int b = v & 3, hf = (v >> 2) & 1, s = v >> 3;
        sel_unit(F, b, 63 - s, hf);
        sel_unit(F, b, s, hf);
    }
}

__device__ __forceinline__ void ph_router(Frame& F) {
    { int t_ = threadIdx.x; asm volatile("" : "+v"(t_)); F.tid = t_; F.lane = t_ & 63; F.wave = __builtin_amdgcn_readfirstlane(t_ >> 6); }
    kargs_t ap = kargs(); inarr_t IN = (inarr_t)ap->in; unsigned char* WS = ap->ws; unsigned* CTL = (unsigned*)(WS + WS_CTL); float* OUT = ap->out; (void)IN; (void)OUT; (void)CTL;
    LAS f32x4* Wl = (LAS f32x4*)(F.lds);
    LAS unsigned* lcnt = (LAS unsigned*)(F.lds + TAB_OFF);
    LAS unsigned* lbase = lcnt + 32;
    LAS unsigned* ler = lcnt + 64;
    LAS float* lgate = (LAS float*)(lcnt + 64 + 256);
    const float* WR = IN[I_WR]; const float* BR = IN[I_BR];
    const float* mod = (const float*)(CTL + CW_MOD);
    bf16* H = (bf16*)(WS + WS_H);
    int* list = (int*)(WS + WS_LIST); unsigned* toker = (unsigned*)(WS + WS_TOKER); float* tokg = (float*)(WS + WS_TOKG);
    unsigned* gcnt = CTL + CW_ECNT;
    const int lane = F.lane;
    for (int idx = F.tid; idx < 8192; idx += 512) { const int l = idx & 63, q = (idx >> 6) & 7, c = (idx >> 9) & 3, j = idx >> 11;
        Wl[idx] = *(const f32x4*)(WR + (size_t)(4 * l + c + 256 * j) * 32 + 4 * q); }
    const int ebit = ((lane >> 5) & 1) * 16 + ((lane >> 4) & 1) * 8 + ((lane >> 3) & 1) * 4 + ((lane >> 2) & 1) * 2 + ((lane >> 1) & 1);
    const float myb = BR[ebit];
    for (int tb = F.vcu; tb < MTOK / 64; tb += F.G) {
        if (F.tid < 32) lcnt[F.tid] = 0u;
        __syncthreads();
        for (int i = 0; i < 8; ++i) {
            const int tl = 8 * F.wave + i, tok = tb * 64 + tl;
            const float* mb = mod + (size_t)(tok >> 12) * 6144;
            const f32x4* xr = (const f32x4*)(OUT + (size_t)tok * 1024) + lane;
            f32x4 v[4]; float s = 0.f;
#pragma unroll
            for (int j = 0; j < 4; ++j) { v[j] = xr[64 * j]; s += (v[j].x * v[j].x + v[j].y * v[j].y) + (v[j].z * v[j].z + v[j].w * v[j].w); }
            const float rstd = 1.0f / sqrtf(wave_sum(s) * (1.f / 1024.f) + EPSN);
            u64* o8 = (u64*)(H + (size_t)tok * 1024) + lane;
            float acc[32];
#pragma unroll
            for (int e = 0; e < 32; ++e) acc[e] = 0.f;
#pragma unroll
            for (int j = 0; j < 4; ++j) {
                const f32x4 gv = ((const f32x4*)IN[I_N2G])[lane + 64 * j], scv = ((const f32x4*)(mb + 4096))[lane + 64 * j], shv = ((const f32x4*)(mb + 3072))[lane + 64 * j];
                const f32x4 y = (v[j] * rstd) * gv * (scv + 1.0f) + shv;
                o8[64 * j] = (u64)pkbf(y.x, y.y) | ((u64)pkbf(y.z, y.w) << 32);
#pragma unroll
                for (int c = 0; c < 4; ++c) { const float hv = y[c];
#pragma unroll
                    for (int q = 0; q < 8; ++q) { const f32x4 w = Wl[((j * 4 + c) * 8 + q) * 64 + lane]; acc[4 * q] += hv * w.x; acc[4 * q + 1] += hv * w.y; acc[4 * q + 2] += hv * w.z; acc[4 * q + 3] += hv * w.w; } }
            }
#pragma unroll
            for (int i2 = 0; i2 < 16; ++i2) { const bool up = lane & 32; const float send = up ? acc[i2] : acc[i2 + 16], keep = up ? acc[i2 + 16] : acc[i2]; acc[i2] = keep + __shfl_xor(send, 32); }
#pragma unroll
            for (int i2 = 0; i2 < 8; ++i2) { const bool up = lane & 16; const float send = up ? acc[i2] : acc[i2 + 8], keep = up ? acc[i2 + 8] : acc[i2]; acc[i2] = keep + __shfl_xor(send, 16); }
#pragma unroll
            for (int i2 = 0; i2 < 4; ++i2) { const bool up = lane & 8; const float send = up ? acc[i2] : acc[i2 + 4], keep = up ? acc[i2 + 4] : acc[i2]; acc[i2] = keep + __shfl_xor(send, 8); }
#pragma unroll
            for (int i2 = 0; i2 < 2; ++i2) { const bool up = lane & 4; const float send = up ? acc[i2] : acc[i2 + 2], keep = up ? acc[i2 + 2] : acc[i2]; acc[i2] = keep + __shfl_xor(send, 4); }
            { const bool up = lane & 2; const float send = up ? acc[0] : acc[1], keep = up ? acc[1] : acc[0]; acc[0] = keep + __shfl_xor(send, 2); }
            float logit = acc[0] + __shfl_xor(acc[0], 1) + myb;
            float tv[4]; int te[4];
            unsigned lu = __float_as_uint(logit); unsigned lkey = lu ^ ((unsigned)((int)lu >> 31) | 0x80000000u);
#pragma unroll
            for (int k = 0; k < 4; ++k) {
                u64 best = ((u64)lkey << 32) | (unsigned)(31 - ebit);
#pragma unroll
                for (int o = 1; o < 64; o <<= 1) { const unsigned bh = __shfl_xor((unsigned)(best >> 32), o), bl = __shfl_xor((unsigned)best, o); const u64 ot = ((u64)bh << 32) | bl; best = ot > best ? ot : best; }
                const int we = 31 - (int)(unsigned)best; te[k] = we;
                const unsigned wk = (unsigned)(best >> 32); const unsigned wu = (wk & 0x80000000u) ? (wk ^ 0x80000000u) : ~wk; tv[k] = __uint_as_float(wu);
                if (ebit == we) lkey = 0u;
            }
            const float e1 = expf(tv[1] - tv[0]), e2 = expf(tv[2] - tv[0]), e3 = expf(tv[3] - tv[0]); const float inv = 1.0f / (1.0f + e1 + e2 + e3);
            if (lane < 4) { const int e = lane == 0 ? te[0] : lane == 1 ? te[1] : lane == 2 ? te[2] : te[3]; const float g = (lane == 0 ? 1.0f : lane == 1 ? e1 : lane == 2 ? e2 : e3) * inv;
                const unsigned lr = __hip_atomic_fetch_add(lcnt + e, 1u, __ATOMIC_RELAXED, __HIP_MEMORY_SCOPE_WORKGROUP);
                ler[tl * 4 + lane] = (unsigned)e | (lr << 8); lgate[tl * 4 + lane] = g; }
        }
        __syncthreads();
        if (F.tid < 32) lbase[F.tid] = __hip_atomic_fetch_add(gcnt + F.tid, lcnt[F.tid], RLX_AGENT);
        __syncthreads();
        if (F.tid < 256) { const unsigned er = ler[F.tid]; const int e = er & 255u; const unsigned rank = lbase[e] + (er >> 8); const int tok = tb * 64 + (F.tid >> 2);
            list[(size_t)e * MTOK + rank] = tok; toker[(size_t)tok * 4 + (F.tid & 3)] = (unsigned)e | (rank << 8); tokg[(size_t)tok * 4 + (F.tid & 3)] = lgate[F.tid]; }
        __syncthreads();
    }
}

__device__ __forceinline__ void moe_table(Frame& F) {
    { int t_ = threadIdx.x; asm volatile("" : "+v"(t_)); F.tid = t_; F.lane = t_ & 63; F.wave = __builtin_amdgcn_readfirstlane(t_ >> 6); }
    kargs_t ap = kargs(); inarr_t IN = (inarr_t)ap->in; unsigned char* WS = ap->ws; unsigned* CTL = (unsigned*)(WS + WS_CTL); float* OUT = ap->out; (void)IN; (void)OUT; (void)CTL;
    LAS int* tab = (LAS int*)(F.lds + TAB_OFF);
    if (F.tid == 0) { int nt = 0;
        for (int e = 0; e < NEXP; ++e) { const int c = (int)__hip_atomic_load(CTL + CW_ECNT + e, RLX_AGENT); tab[512 + e] = c; const int n = (c + 255) >> 8; for (int r = 0; r < n; ++r) tab[1 + nt++] = e | (r << 8); }
        tab[0] = nt; }
    __syncthreads();
}
struct MoeOrder {
    const LAS int* tab; int ncol, G, c; const int* list;
    __device__ __forceinline__ bool next(int i, pg8::Unit& u) const {
        const int nM = tab[0], nN = ncol, nwg = nM * nN; const long L = (long)i * G + c; if (L >= nwg) return false;
        int wgid = (int)L; { const int q = nwg / 8, r = nwg % 8, xcd = wgid % 8, off = wgid / 8; wgid = (xcd < r ? xcd * (q + 1) : r * (q + 1) + (xcd - r) * q) + off; }
        const int nig = 8 * nN, gid = wgid / nig, fm = gid * 8, gsz = (nM - fm) < 8 ? (nM - fm) : 8;
        const int pm = fm + ((wgid % nig) % gsz), cn = (wgid % nig) / gsz; const int er = tab[1 + pm];
        u.pm = pm; u.e = er & 255; u.r = er >> 8; u.pn = u.e * ncol + cn; return true;
    }
    __device__ __forceinline__ const int* rows(const pg8::Unit& u, int& cnt) const { cnt = tab[512 + u.e]; return list + (size_t)u.e * MTOK; }
};
struct MergeOrder {
    pg8::StaticOrder so;
    __device__ __forceinline__ bool next(int i, pg8::Unit& u) const { if (!so.next(i >> 1, u)) return false; if (i & 1) { u.pm += 64; u.pn += 4; } return true; }
    __device__ __forceinline__ const int* rows(const pg8::Unit&, int& cnt) const { cnt = 0; return nullptr; }
};

#ifndef DBG_NPH
#define DBG_NPH 11
#endif
__device__ __forceinline__ void ph_combine(Frame& F) {
    { int t_ = threadIdx.x; asm volatile("" : "+v"(t_)); F.tid = t_; F.lane = t_ & 63; F.wave = __builtin_amdgcn_readfirstlane(t_ >> 6); }
    kargs_t ap = kargs(); inarr_t IN = (inarr_t)ap->in; unsigned char* WS = ap->ws; unsigned* CTL = (unsigned*)(WS + WS_CTL); float* OUT = ap->out; (void)IN; (void)OUT; (void)CTL;
    LAS int* tab = (LAS int*)(F.lds + TAB_OFF);
    if (F.tid == 0) { int acc = 0; for (int e = 0; e < NEXP; ++e) { tab[e] = acc; const int c = (int)__hip_atomic_load(CTL + CW_ECNT + e, RLX_AGENT); acc += ((c + 255) >> 8) << 8; } }
    __syncthreads();
    const float* mod = (const float*)(CTL + CW_MOD);
    const bf16* Y = (const bf16*)(WS + (DBG_NPH == 9 ? WS_ACT : WS_YBUF)); const unsigned* toker = (const unsigned*)(WS + WS_TOKER); const float* tokg = (const float*)(WS + WS_TOKG);
    const int gw = F.vcu * NWAVES + F.wave, NGW = F.G * NWAVES, lane = F.lane;
    for (int tok = gw; tok < MTOK; tok += NGW) {
        const float* g2 = mod + (size_t)(tok >> 12) * 6144 + 5120;
        f32x4 a[4];
#pragma unroll
        for (int j = 0; j < 4; ++j) a[j] = (f32x4){0.f, 0.f, 0.f, 0.f};
#pragma unroll
        for (int k = 0; k < 4; ++k) { const unsigned er = toker[(size_t)tok * 4 + k]; const float g = tokg[(size_t)tok * 4 + k]; const int slot = tab[er & 255u] + (int)(er >> 8);
            const u64* yr = (const u64*)(Y + (size_t)slot * 1024) + lane;
            float gg = g; if (DBG_NPH == 8) { yr = (const u64*)((const bf16*)(WS + WS_H) + (size_t)tok * 1024) + lane; gg = g * (float)((er & 255u) + 1u) * 0.0625f; }
#pragma unroll
            for (int j = 0; j < 4; ++j) { const u64 w = yr[64 * j]; const unsigned lo = (unsigned)w, hi = (unsigned)(w >> 32); a[j].x += gg * bflo(lo); a[j].y += gg * bfhi(lo); a[j].z += gg * bflo(hi); a[j].w += gg * bfhi(hi); } }
        f32x4* orow = (f32x4*)(OUT + (size_t)tok * 1024) + lane;
#pragma unroll
        for (int j = 0; j < 4; ++j) { const f32x4 gv = ((const f32x4*)g2)[lane + 64 * j]; orow[64 * j] = orow[64 * j] + gv * a[j]; }
    }
}


constexpr int CW_HASH = 12288;
#ifndef DBG_HMASK
#define DBG_HMASK 0x3ff
#endif
__device__ __forceinline__ void dbg_hash(Frame& F) {
    { int t_ = threadIdx.x; asm volatile("" : "+v"(t_)); F.tid = t_; F.lane = t_ & 63; F.wave = __builtin_amdgcn_readfirstlane(t_ >> 6); }
    kargs_t ap = kargs(); unsigned char* WS = ap->ws; unsigned* CTL = (unsigned*)(WS + WS_CTL);
    const size_t offs[10] = {WS_CTL + (size_t)CW_MOD * 4, WS_WIN, WS_H, WS_Z, WS_QN, WS_YAB, WS_MASK, WS_YAB + (size_t)MTOK * 1024, WS_MRG, 0};
    const size_t lens[10] = {24576 * 4, 208 * MiB, 32 * MiB, 176 * MiB, 32 * MiB, 16 * MiB, 8 * MiB, 16 * MiB, 32 * MiB, 64 * MiB};
    for (int k = 0; k < 10; ++k) {
        const unsigned* p = k == 9 ? (const unsigned*)ap->out : (const unsigned*)(WS + offs[k]); const size_t n = lens[k] / 4;
        unsigned h = 0u;
        for (size_t i = (size_t)F.bx * 512 + F.tid; i < n; i += (size_t)F.G * 512) h += p[i] * (unsigned)(2 * i + 1);
        atomicAdd(CTL + CW_HASH + k, h);
    }
}
__device__ __forceinline__ void dbg_emit(Frame& F) {
    kargs_t ap = kargs(); unsigned char* WS = ap->ws; unsigned* CTL = (unsigned*)(WS + WS_CTL); float* OUT = ap->out;
    for (size_t i = (size_t)F.bx * 512 + threadIdx.x; i < (size_t)MTOK * 1024; i += (size_t)F.G * 512) {
        float v = 0.f;
        if (i < 10) { float sc = (DBG_HMASK >> i) & 1 ? 1.f : 0.f; v = sc * (1.0f + (float)(CTL[CW_HASH + i] & 0x7fffffu) * (1.0f / 8388608.0f)); }
        OUT[i] = v;
    }
}
__global__ void __launch_bounds__(NWAVES * 64, 2) mk_fwd(Args args) {
    extern __shared__ __attribute__((aligned(16))) unsigned char lds[];
    Frame F;
    F.lds = (LAS unsigned char*)lds;
    F.MISC = (volatile LAS unsigned*)(F.lds + MISC_OFF);
    F.tid = threadIdx.x; F.lane = F.tid & 63; F.wave = __builtin_amdgcn_readfirstlane(F.tid >> 6);
    F.G = gridDim.x; F.bx = blockIdx.x; { const int bx = blockIdx.x; F.vcu = (F.G % 8 == 0) ? (bx % 8) * (F.G / 8) + bx / 8 : bx; }
    for (int u = F.tid; u < (LDS_BYTES - LDSCTL_OFF) / 4; u += NWAVES * 64) ((LAS unsigned*)(F.lds + LDSCTL_OFF))[u] = 0u;
    __syncthreads();
    XcdBarrier bar; bar.bar = (unsigned*)(args.ws + WS_CTL) + CW_BAR; bar.x = 0; bar.st = nullptr;
    if (N_LAUNCHES == 1) bar = xcd_barrier_post((unsigned*)(args.ws + WS_CTL) + CW_BAR, F.MISC + 8);
#define GRID_BAR() do { if (N_LAUNCHES == 1) { bar.bar = (unsigned*)(kargs()->ws + WS_CTL) + CW_BAR; xcd_barrier(bar); } } while (0)
    const int lo = args.ph_lo, hi = args.ph_hi;
#ifndef PH_MASK
#define PH_MASK 0x7ff
#endif
#define PH(k) ((((PH_MASK) >> (k)) & 1) && lo <= (k) && (k) < hi)
#define BOTH(k) (PH(k) && PH((k) + 1))
#define VIEWS() kargs_t ap = kargs(); inarr_t IN = (inarr_t)ap->in; unsigned char* WS = ap->ws; unsigned* CTL = (unsigned*)(WS + WS_CTL); float* OUT = ap->out; (void)IN; (void)OUT; (void)CTL; \
    bf16* Hb = (bf16*)(WS + WS_H); bf16* Zb = (bf16*)(WS + WS_Z); (void)Hb; (void)Zb
    if (PH(0)) { ph_adaln(F); if (BOTH(0)) GRID_BAR(); }
    if (PH(1)) { ph_prologue(F); if (BOTH(1)) GRID_BAR(); }
    if (PH(2)) {
        VIEWS();
        pg8::Gemm g{Hb, (const bf16*)(WS + WS_WIN), MTOK, ZW, 1024}; pg8::StaticOrder S; S.init(MTOK, ZW, F.G, F.bx);
        pg8::EpiBf16 E{Zb, ZW, nullptr, 0};
        pg8::gemm_phase<pg8::EpiBf16, pg8::StaticOrder, false>(F.lds + RING_OFF, g, S, E);
        if (BOTH(2)) GRID_BAR();
    }
    if (PH(3)) { ph_select(F); if (BOTH(3)) GRID_BAR(); }
    if (PH(4)) {
        VIEWS();
        const bf16* Qn = (const bf16*)(WS + WS_QN); const bf16* Kn = (const bf16*)(WS + WS_KN); bf16* YB = (bf16*)(WS + WS_YAB) + (size_t)MTOK * 512;
        for (int v = F.vcu; v < 256; v += F.G) { const int bh = v >> 3, s = v & 7;
            attn_body::attn_unit(bh >> 3, bh & 7, 15 - s, Qn, Kn, Zb + ZC_V, ZW, YB, (const u64*)(WS + WS_MASK), (char*)lds + RING_OFF);
            attn_body::attn_unit(bh >> 3, bh & 7, s, Qn, Kn, Zb + ZC_V, ZW, YB, (const u64*)(WS + WS_MASK), (char*)lds + RING_OFF); }
        if (BOTH(4)) GRID_BAR();
    }
    if (PH(5)) {
        VIEWS();
        pg8::Gemm g{(const bf16*)(WS + WS_YAB), (const bf16*)(WS + WS_PAB), 2 * MTOK, 2048, 512}; MergeOrder S; S.so.init(MTOK, 1024, F.G, F.bx);
        pg8::EpiMerge E{(bf16*)(WS + WS_MRG), Zb, ZW, ZC_GA, ZC_GBR};
        pg8::gemm_phase<pg8::EpiMerge, MergeOrder, false>(F.lds + RING_OFF, g, S, E);
        if (BOTH(5)) GRID_BAR();
    }
    if (PH(6)) {
        VIEWS();
        pg8::Gemm g{(const bf16*)(WS + WS_MRG), (const bf16*)(WS + WS_WO), MTOK, 1024, 1024}; pg8::StaticOrder S; S.init(MTOK, 1024, F.G, F.bx);
        pg8::EpiResid E{IN[I_X], OUT, (const float*)(CTL + CW_MOD) + 2048};
        pg8::gemm_phase<pg8::EpiResid, pg8::StaticOrder, false>(F.lds + RING_OFF, g, S, E);
        if (BOTH(6)) GRID_BAR();
    }
    if (PH(7)) { ph_router(F); if (BOTH(7)) GRID_BAR(); }
    if (PH(8)) {
        moe_table(F);
        VIEWS();
        pg8::Gemm g{Hb, (const bf16*)(WS + WS_WGU), MTOK, 2048 * NEXP, 1024}; MoeOrder S{(const LAS int*)(F.lds + TAB_OFF), 8, F.G, F.bx, (const int*)(WS + WS_LIST)};
        pg8::EpiSwiGLU E{(bf16*)(WS + WS_ACT), IN[I_BGU]};
        pg8::gemm_phase<pg8::EpiSwiGLU, MoeOrder, true>(F.lds + RING_OFF, g, S, E);
        if (BOTH(8)) GRID_BAR();
    }
    if (PH(9)) {
        moe_table(F);
        VIEWS();
        pg8::Gemm g{(const bf16*)(WS + WS_ACT), (const bf16*)(WS + WS_WD), MAXSLOT, 1024 * NEXP, 1024}; MoeOrder S{(const LAS int*)(F.lds + TAB_OFF), 4, F.G, F.bx, (const int*)(WS + WS_LIST)};
        pg8::EpiBf16 E{(bf16*)(WS + WS_YBUF), 1024, IN[I_BD], 1024};
        pg8::gemm_phase<pg8::EpiBf16, MoeOrder, false>(F.lds + RING_OFF, g, S, E);
        if (BOTH(9)) GRID_BAR();
    }
    if (PH(10)) { ph_combine(F); }
    if (lo == 20) dbg_hash(F);
    if (lo == 21) dbg_emit(F);
#undef PH
#undef BOTH
#undef GRID_BAR
#undef VIEWS
}

extern "C" void kernel_launch(void* const* d_in, const int* in_sizes, int n_in, void* d_out, int out_size, void* d_ws, size_t ws_size, hipStream_t stream) {
    static int grid = 0;
    if (grid == 0) {
        if (n_in != 19 || in_sizes[0] != MTOK * 1024 || out_size != MTOK * 1024 || ws_size < WS_END) { fprintf(stderr, "kernel_launch: unexpected shapes / workspace (n_in %d, ws %zu < %zu)\n", n_in, ws_size, (size_t)WS_END); grid = -1; return; }
        int dev = 0, cus = 0, per_cu = 0;
        if (hipGetDevice(&dev) != hipSuccess || hipDeviceGetAttribute(&cus, hipDeviceAttributeMultiprocessorCount, dev) != hipSuccess) { grid = -1; return; }
        if (hipFuncSetAttribute((const void*)mk_fwd, hipFuncAttributeMaxDynamicSharedMemorySize, LDS_BYTES) != hipSuccess) { fprintf(stderr, "kernel_launch: hipFuncSetAttribute failed\n"); grid = -1; return; }
        if (hipOccupancyMaxActiveBlocksPerMultiprocessor(&per_cu, (const void*)mk_fwd, NWAVES * 64, LDS_BYTES) != hipSuccess || per_cu < 1) fprintf(stderr, "kernel_launch: occupancy query reports %d blocks per CU\n", per_cu);
        (void)hipGetLastError();
        grid = cus;
    }
    if (grid < 0) return;
    if (hipMemsetAsync((char*)d_ws + WS_CTL, 0, CTL_ZERO_BYTES, stream) != hipSuccess) return;
    Args a{};
    for (int i = 0; i < 19; ++i) a.in[i] = (const float*)d_in[i];
    a.out = (float*)d_out; a.ws = (unsigned char*)d_ws;
    if (N_LAUNCHES == 1) { a.ph_lo = 0; a.ph_hi = N_PHASES; hipLaunchKernelGGL(mk_fwd, dim3(grid), dim3(NWAVES * 64), LDS_BYTES, stream, a); }
    else { for (int p = 0; p < DBG_NPH; ++p) { a.ph_lo = p; a.ph_hi = p + 1; hipLaunchKernelGGL(mk_fwd, dim3(grid), dim3(NWAVES * 64), LDS_BYTES, stream, a); }
        if (DBG_NPH == 7) { a.ph_lo = 20; a.ph_hi = 21; hipLaunchKernelGGL(mk_fwd, dim3(grid), dim3(NWAVES * 64), LDS_BYTES, stream, a); a.ph_lo = 21; a.ph_hi = 22; hipLaunchKernelGGL(mk_fwd, dim3(grid), dim3(NWAVES * 64), LDS_BYTES, stream, a); }
        if (DBG_NPH == 9 || DBG_NPH == 8) { a.ph_lo = 10; a.ph_hi = 11; hipLaunchKernelGGL(mk_fwd, dim3(grid), dim3(NWAVES * 64), LDS_BYTES, stream, a); } }
}
```

```cpp
#include <hip/hip_runtime.h>
#include <cstdio>
#include <cstdint>

#ifndef MK_N_LAUNCHES
#define MK_N_LAUNCHES 1
#endif

namespace pg8 {
#define PG8_LAS __attribute__((address_space(3)))
typedef unsigned short bf16_t;
typedef short bf16x8 __attribute__((ext_vector_type(8)));
typedef float f32x4 __attribute__((ext_vector_type(4)));
typedef unsigned u32x4 __attribute__((ext_vector_type(4)));
typedef unsigned u32x2 __attribute__((ext_vector_type(2)));
typedef int i32x4 __attribute__((ext_vector_type(4)));
typedef int i32x8 __attribute__((ext_vector_type(8)));
constexpr int BM = 256, BK = 64, HALF = 128, HTB = HALF * BK * 2, STAGE_BYTES = 8 * HTB, NXCD = 8, WGM = 8;

__host__ __device__ __forceinline__ int lds_byte(int r, int c) { const int st = (r >> 4) * 2 + (c >> 5), rr = r & 15, cc = c & 31, ob = rr * 64 + cc * 2; return st * 1024 + (ob ^ (((ob >> 9) & 1) << 5)); }
__host__ __device__ __forceinline__ void stage_rc(int b, int& R, int& C) { const int st = b / 1024, sb = b % 1024, swz = sb ^ (((sb >> 9) & 1) << 5); R = (st >> 1) * 16 + swz / 64; C = (st & 1) * 32 + (swz % 64) / 2; }
__host__ __device__ __forceinline__ int perm32(int rho) { const int n = rho >> 4, i = rho & 15; return 8 * (i >> 2) + 4 * n + (i & 3); }

struct Unit { int pm, pn; int e, r; };
struct Gemm { const bf16_t* A; const bf16_t* Bt; int M, N, K; int scaleA, scaleB; };

struct StaticOrder {
    int nM, nN, nwg, G, c;
    __host__ __device__ void init(int M, int N, int G_, int c_) { nM = M / BM; nN = N / BM; nwg = nM * nN; G = G_; c = c_; }
    __host__ __device__ bool next(int i, Unit& u) const {
        const long L = (long)i * G + c; if (L >= nwg) return false;
        int wgid = (int)L; { const int q = nwg / NXCD, r = nwg % NXCD, xcd = wgid % NXCD, off = wgid / NXCD; wgid = (xcd < r ? xcd * (q + 1) : r * (q + 1) + (xcd - r) * q) + off; }
        const int nig = WGM * nN, gid = wgid / nig, fm = gid * WGM, gsz = (nM - fm) < WGM ? (nM - fm) : WGM;
        u.pm = fm + ((wgid % nig) % gsz); u.pn = (wgid % nig) / gsz; u.e = 0; u.r = 0; return true;
    }
    __device__ __forceinline__ const int* rows(const Unit&, int& cnt) const { cnt = 0; return nullptr; }
};

__device__ __forceinline__ unsigned cvt_pk_bf16(float lo, float hi) { unsigned r; asm volatile("v_cvt_pk_bf16_f32 %0, %1, %2" : "=v"(r) : "v"(lo), "v"(hi)); return r; }
__device__ __forceinline__ float bf_lo(unsigned w) { return __uint_as_float(w << 16); }
__device__ __forceinline__ float bf_hi(unsigned w) { return __uint_as_float(w & 0xffff0000u); }
__device__ __forceinline__ float fast_sigmoid(float x) { return __builtin_amdgcn_rcpf(1.0f + __builtin_amdgcn_exp2f(-1.4426950408889634f * x)); }

struct EpiBf16 {
    static constexpr bool PERM = true;
    bf16_t* O; int ldc; const float* bias; int colmod;
    __device__ __forceinline__ void operator()(const f32x4 (&acc)[2][2][4][2], const Unit& u, int wr, int wc, int fr, int fq) const {
        const int row0 = u.pm * BM + wr * 64 + fr; int colt = u.pn * BM; if (colmod) colt %= colmod;
        const int col0 = colt + wc * 32 + 8 * fq, bcol0 = u.pn * BM + wc * 32 + 8 * fq;
        f32x4 bv[2][2];
#pragma unroll
        for (int bj = 0; bj < 2; ++bj)
#pragma unroll
            for (int n = 0; n < 2; ++n) bv[bj][n] = bias ? *(const f32x4*)(bias + bcol0 + bj * HALF + 4 * n) : (f32x4){0.f, 0.f, 0.f, 0.f};
#pragma unroll
        for (int ai = 0; ai < 2; ++ai)
#pragma unroll
            for (int m = 0; m < 4; ++m) { bf16_t* rowp = O + (size_t)(row0 + ai * HALF + m * 16) * ldc + col0;
#pragma unroll
                for (int bj = 0; bj < 2; ++bj) { const f32x4 v0 = acc[ai][bj][m][0] + bv[bj][0], v1 = acc[ai][bj][m][1] + bv[bj][1];
                    u32x4 w; w.x = cvt_pk_bf16(v0[0], v0[1]); w.y = cvt_pk_bf16(v0[2], v0[3]); w.z = cvt_pk_bf16(v1[0], v1[1]); w.w = cvt_pk_bf16(v1[2], v1[3]);
                    *(u32x4*)(rowp + bj * HALF) = w; } }
    }
};

struct EpiMerge {
    static constexpr bool PERM = true;
    bf16_t* MRG; const bf16_t* Z; int zw, gcolA, gcolB;
    __device__ __forceinline__ void operator()(const f32x4 (&acc)[2][2][4][2], const Unit& u, int wr, int wc, int fr, int fq) const {
        const int br = u.pm >= 64 ? 1 : 0, pm = u.pm - 64 * br, pn = u.pn - 4 * br;
        const int row0 = pm * BM + wr * 64 + fr, col0 = pn * BM + wc * 32 + 8 * fq, gcol = br ? gcolB : gcolA;
#pragma unroll
        for (int ai = 0; ai < 2; ++ai)
#pragma unroll
            for (int m = 0; m < 4; ++m) { const size_t row = (size_t)(row0 + ai * HALF + m * 16);
#pragma unroll
                for (int bj = 0; bj < 2; ++bj) {
                    const u32x4 g = *(const u32x4*)(Z + row * zw + gcol + col0 + bj * HALF);
                    bf16_t* op = MRG + row * 1024 + col0 + bj * HALF;
                    f32x4 v0 = acc[ai][bj][m][0], v1 = acc[ai][bj][m][1];
                    v0[0] *= fast_sigmoid(bf_lo(g.x)); v0[1] *= fast_sigmoid(bf_hi(g.x)); v0[2] *= fast_sigmoid(bf_lo(g.y)); v0[3] *= fast_sigmoid(bf_hi(g.y));
                    v1[0] *= fast_sigmoid(bf_lo(g.z)); v1[1] *= fast_sigmoid(bf_hi(g.z)); v1[2] *= fast_sigmoid(bf_lo(g.w)); v1[3] *= fast_sigmoid(bf_hi(g.w));
                    if (br) { const u32x4 p = *(const u32x4*)op;
                        v0[0] += bf_lo(p.x); v0[1] += bf_hi(p.x); v0[2] += bf_lo(p.y); v0[3] += bf_hi(p.y); v1[0] += bf_lo(p.z); v1[1] += bf_hi(p.z); v1[2] += bf_lo(p.w); v1[3] += bf_hi(p.w); }
                    u32x4 w; w.x = cvt_pk_bf16(v0[0], v0[1]); w.y = cvt_pk_bf16(v0[2], v0[3]); w.z = cvt_pk_bf16(v1[0], v1[1]); w.w = cvt_pk_bf16(v1[2], v1[3]);
                    *(u32x4*)op = w; } }
    }
};

struct EpiResid {
    static constexpr bool PERM = false;
    const float* X; float* out; const float* gate;
    __device__ __forceinline__ void operator()(const f32x4 (&acc)[2][2][4][2], const Unit& u, int wr, int wc, int fr, int fq) const {
        const int row0 = u.pm * BM + wr * 64 + fr, col0 = u.pn * BM + wc * 32 + 4 * fq;
        const float* gb = gate + (size_t)((u.pm * BM) >> 12) * 6144;
        f32x4 gv[2][2];
#pragma unroll
        for (int bj = 0; bj < 2; ++bj)
#pragma unroll
            for (int n = 0; n < 2; ++n) gv[bj][n] = *(const f32x4*)(gb + col0 + bj * HALF + n * 16);
#pragma unroll
        for (int ai = 0; ai < 2; ++ai)
#pragma unroll
            for (int m = 0; m < 4; ++m) { const size_t off = (size_t)(row0 + ai * HALF + m * 16) * 1024 + col0;
#pragma unroll
                for (int bj = 0; bj < 2; ++bj)
#pragma unroll
                    for (int n = 0; n < 2; ++n) { const f32x4 xv = *(const f32x4*)(X + off + bj * HALF + n * 16);
                        *(f32x4*)(out + off + bj * HALF + n * 16) = xv + gv[bj][n] * acc[ai][bj][m][n]; } }
    }
};

struct EpiSwiGLU {
    static constexpr bool PERM = true;
    bf16_t* ACT; const float* bgu;
    __device__ __forceinline__ void operator()(const f32x4 (&acc)[2][2][4][2], const Unit& u, int wr, int wc, int fr, int fq) const {
        const int e = u.pn >> 3, cn = u.pn & 7;
        const int row0 = u.pm * BM + wr * 64 + fr, col0 = cn * 128 + wc * 32 + 8 * fq;
        const float* bg = bgu + (size_t)e * 2048 + col0;
        f32x4 bG[2], bL[2];
#pragma unroll
        for (int n = 0; n < 2; ++n) { bG[n] = *(const f32x4*)(bg + 4 * n); bL[n] = *(const f32x4*)(bg + 1024 + 4 * n); }
#pragma unroll
        for (int ai = 0; ai < 2; ++ai)
#pragma unroll
            for (int m = 0; m < 4; ++m) { float o[8];
#pragma unroll
                for (int n = 0; n < 2; ++n)
#pragma unroll
                    for (int j = 0; j < 4; ++j) { const float g = fminf(acc[ai][0][m][n][j] + bG[n][j], 7.0f); float l = acc[ai][1][m][n][j] + bL[n][j]; l = fminf(fmaxf(l, -7.0f), 7.0f);
                        o[4 * n + j] = g * fast_sigmoid(1.702f * g) * (l + 1.0f); }
                u32x4 w; w.x = cvt_pk_bf16(o[0], o[1]); w.y = cvt_pk_bf16(o[2], o[3]); w.z = cvt_pk_bf16(o[4], o[5]); w.w = cvt_pk_bf16(o[6], o[7]);
                *(u32x4*)(ACT + (size_t)(row0 + ai * HALF + m * 16) * 1024 + col0) = w; }
    }
};

__device__ __forceinline__ unsigned pk4_fp8(float a, float b, float c, float d) { int w = 0; w = __builtin_amdgcn_cvt_pk_fp8_f32(a, b, w, false); w = __builtin_amdgcn_cvt_pk_fp8_f32(c, d, w, true); return (unsigned)w; }
struct EpiSwiGLU8 {
    static constexpr bool PERM = true;
    unsigned char* ACT; const float* bgu;
    __device__ __forceinline__ void operator()(const f32x4 (&acc)[2][2][4][2], const Unit& u, int wr, int wc, int fr, int fq) const {
        const int e = u.pn >> 3, cn = u.pn & 7;
        const int row0 = u.pm * BM + wr * 64 + fr, col0 = cn * 128 + wc * 32 + 8 * fq;
        const float* bg = bgu + (size_t)e * 2048 + col0;
        f32x4 bG[2], bL[2];
#pragma unroll
        for (int n = 0; n < 2; ++n) { bG[n] = *(const f32x4*)(bg + 4 * n); bL[n] = *(const f32x4*)(bg + 1024 + 4 * n); }
#pragma unroll
        for (int ai = 0; ai < 2; ++ai)
#pragma unroll
            for (int m = 0; m < 4; ++m) { float o[8];
#pragma unroll
                for (int n = 0; n < 2; ++n)
#pragma unroll
                    for (int j = 0; j < 4; ++j) { const float g = fminf(acc[ai][0][m][n][j] + bG[n][j], 7.0f); float l = acc[ai][1][m][n][j] + bL[n][j]; l = fminf(fmaxf(l, -7.0f), 7.0f);
                        o[4 * n + j] = g * fast_sigmoid(1.702f * g) * (l + 1.0f); }
                u32x2 w; w.x = pk4_fp8(o[0], o[1], o[2], o[3]); w.y = pk4_fp8(o[4], o[5], o[6], o[7]);
                *(u32x2*)(ACT + (size_t)(row0 + ai * HALF + m * 16) * 1024 + col0) = w; }
    }
};

template <class Epi, class Sched, bool GATHER = false, bool FP8 = false>
__device__ __forceinline__ void gemm_phase(PG8_LAS unsigned char* lds, const Gemm g, const Sched& S, const Epi& E) {
    int tid_ = threadIdx.x; asm volatile("" : "+v"(tid_));
    const int tid = tid_, wid = __builtin_amdgcn_readfirstlane(tid >> 6), lane = tid & 63, wr = wid >> 2, wc = wid & 3, fr = lane & 15, fq = lane >> 4;
    const int K = g.K, KB = FP8 ? K : 2 * K, nt = KB / 128;
    unsigned voffB[2]; unsigned offA[2][2], offAn[2][2]; int Rr[2], Cc[2];
#pragma unroll
    for (int i = 0; i < 2; ++i) { int R, C; stage_rc(tid * 16 + i * 8192, R, C); const int Rb = Epi::PERM ? ((R & ~31) + perm32(R & 31)) : R; Rr[i] = R; Cc[i] = C;
        voffB[i] = (unsigned)(Rb * KB + C * 2); }
    const size_t kstep = (size_t)(BK * 2);
    const size_t hstep = (size_t)HALF * KB;
    const size_t tstep = 2 * hstep;
    const unsigned ldsw = (unsigned)wid * 1024u;
    const int aoff = lds_byte(wr * 64 + fr, fq * 8), boff = lds_byte(wc * 32 + fr, fq * 8);
#define PG8_SA(b, h) (((b) * 2 + (h)) * HTB)
#define PG8_SB(b, h) ((4 + (b) * 2 + (h)) * HTB)
#define PG8_STAGE(bufoff, gbase, voff) do { _Pragma("unroll") for (int _i = 0; _i < 2; ++_i) \
        __builtin_amdgcn_global_load_lds((const unsigned*)((const char*)(gbase) + (voff)[_i]), (PG8_LAS unsigned*)(lds + (bufoff) + ldsw + _i * 8192), 16, 0, 0); } while (0)
#define PG8_LD8(off_) __builtin_shufflevector(*(const PG8_LAS i32x4*)(lds + (off_)), *(const PG8_LAS i32x4*)(lds + (off_) + 1024), 0, 1, 2, 3, 4, 5, 6, 7)
#define PG8_LDA(dst, b, h) do { if constexpr (FP8) { _Pragma("unroll") for (int m = 0; m < 4; ++m) dst##8[m] = PG8_LD8(PG8_SA(b, h) + aoff + m * 2048); } \
        else { _Pragma("unroll") for (int m = 0; m < 4; ++m) _Pragma("unroll") for (int k = 0; k < 2; ++k) dst[m][k] = *(const PG8_LAS bf16x8*)(lds + PG8_SA(b, h) + aoff + m * 2048 + k * 1024); } } while (0)
#define PG8_LDB(dst, b, h) do { if constexpr (FP8) { _Pragma("unroll") for (int n = 0; n < 2; ++n) dst##8[n] = PG8_LD8(PG8_SB(b, h) + boff + n * 2048); } \
        else { _Pragma("unroll") for (int n = 0; n < 2; ++n) _Pragma("unroll") for (int k = 0; k < 2; ++k) dst[n][k] = *(const PG8_LAS bf16x8*)(lds + PG8_SB(b, h) + boff + n * 2048 + k * 1024); } } while (0)
#define PG8_CAT8(x) __builtin_shufflevector(__builtin_bit_cast(i32x4, (x)[0]), __builtin_bit_cast(i32x4, (x)[1]), 0, 1, 2, 3, 4, 5, 6, 7)
#define PG8_MMA(ai, bj, At, Bt) do { __builtin_amdgcn_s_setprio(1); \
        if constexpr (FP8) { _Pragma("unroll") for (int m = 0; m < 4; ++m) _Pragma("unroll") for (int n = 0; n < 2; ++n) \
            asm volatile("v_mfma_scale_f32_16x16x128_f8f6f4 %0, %1, %2, %0, %3, %4 op_sel_hi:[0,0,0]" : "+v"(acc[ai][bj][m][n]) : "v"(Bt##8[n]), "v"(At##8[m]), "v"(scB_), "v"(scA_)); } \
        else { _Pragma("unroll") for (int m = 0; m < 4; ++m) _Pragma("unroll") for (int n = 0; n < 2; ++n) _Pragma("unroll") for (int k = 0; k < 2; ++k) \
            acc[ai][bj][m][n] = __builtin_amdgcn_mfma_f32_16x16x32_bf16(Bt[n][k], At[m][k], acc[ai][bj][m][n], 0, 0, 0); } __builtin_amdgcn_s_setprio(0); } while (0)
#define PG8_WAIT_V(n) asm volatile("s_waitcnt vmcnt(" #n ")" ::: "memory")
#define PG8_WAIT_L(n) asm volatile("s_waitcnt lgkmcnt(" #n ")" ::: "memory")
#define PG8_BAR __builtin_amdgcn_s_barrier()
#define PG8_SCHED __builtin_amdgcn_sched_barrier(0)
#define PG8_AOFFS(dst, U) do { if constexpr (GATHER) { int cnt_; const int* rl_ = S.rows(U, cnt_); \
        _Pragma("unroll") for (int h_ = 0; h_ < 2; ++h_) _Pragma("unroll") for (int i_ = 0; i_ < 2; ++i_) { const int rr_ = (U).r * 256 + h_ * HALF + Rr[i_]; const int tk_ = rr_ < cnt_ ? rl_[rr_] : 0; \
            dst[h_][i_] = (unsigned)tk_ * (unsigned)KB + (unsigned)(Cc[i_] * 2); } } \
      else { _Pragma("unroll") for (int h_ = 0; h_ < 2; ++h_) _Pragma("unroll") for (int i_ = 0; i_ < 2; ++i_) dst[h_][i_] = (unsigned)((h_ * HALF + Rr[i_]) * KB + Cc[i_] * 2); } } while (0)
    Unit cur, nxt; int ui = 0;
    if (!S.next(0, cur)) return;
    f32x4 acc[2][2][4][2];
#pragma unroll
    for (int a = 0; a < 2; ++a)
#pragma unroll
        for (int b = 0; b < 2; ++b)
#pragma unroll
            for (int m = 0; m < 4; ++m)
#pragma unroll
                for (int n = 0; n < 2; ++n) { acc[a][b][m][n] = (f32x4){0.f, 0.f, 0.f, 0.f}; asm volatile("" : "+v"(acc[a][b][m][n])); }
    int scA_ = g.scaleA, scB_ = g.scaleB; asm volatile("" : "+v"(scA_), "+v"(scB_));
    bf16x8 At[4][2], B0[2][2], B1[2][2]; i32x8 At8[4], B08[2], B18[2];
    const char* cA = GATHER ? (const char*)g.A : (const char*)g.A + (size_t)cur.pm * tstep; const char* cB = (const char*)g.Bt + (size_t)cur.pn * tstep;
    PG8_AOFFS(offA, cur);
    PG8_STAGE(PG8_SB(0, 0), cB, voffB); PG8_STAGE(PG8_SB(0, 1), cB + hstep, voffB); PG8_STAGE(PG8_SA(0, 0), cA, offA[0]); PG8_STAGE(PG8_SA(0, 1), cA, offA[1]);
    if (wr == 1) PG8_BAR;
    PG8_WAIT_V(2); PG8_BAR;
    PG8_STAGE(PG8_SB(1, 0), cB + kstep, voffB); PG8_STAGE(PG8_SA(1, 0), cA + kstep, offA[0]); PG8_STAGE(PG8_SB(1, 1), cB + hstep + kstep, voffB);
    PG8_WAIT_V(6); PG8_BAR;
    for (;;) {
        const bool has_next = S.next(ui + 1, nxt);
        const char* nA = has_next ? (GATHER ? (const char*)g.A : (const char*)g.A + (size_t)nxt.pm * tstep) : cA; const char* nB = has_next ? (const char*)g.Bt + (size_t)nxt.pn * tstep : cB;
        if constexpr (GATHER) { if (has_next) { PG8_AOFFS(offAn, nxt); } else {
#pragma unroll
            for (int h = 0; h < 2; ++h)
#pragma unroll
                for (int i = 0; i < 2; ++i) offAn[h][i] = offA[h][i]; } }
        else {
#pragma unroll
            for (int h = 0; h < 2; ++h)
#pragma unroll
                for (int i = 0; i < 2; ++i) offAn[h][i] = offA[h][i]; }
        for (int t = 0; t < nt; t += 2) {
            const bool last = (t == nt - 2);
            const char* a1 = cA + (size_t)(t + 1) * kstep;
            const char* a2 = last ? nA : cA + (size_t)(t + 2) * kstep; const char* b2 = last ? nB : cB + (size_t)(t + 2) * kstep;
            const char* a3 = a2 + kstep; const char* b3 = b2 + kstep;
            unsigned o2[2][2];
#pragma unroll
            for (int h = 0; h < 2; ++h)
#pragma unroll
                for (int i = 0; i < 2; ++i) o2[h][i] = (GATHER && last) ? offAn[h][i] : offA[h][i];
            PG8_LDB(B0, 0, 0); PG8_LDB(B1, 0, 1); PG8_SCHED; PG8_LDA(At, 0, 0); PG8_STAGE(PG8_SA(1, 1), a1, offA[1]);
            PG8_WAIT_V(8); PG8_WAIT_L(0); PG8_BAR; PG8_MMA(0, 0, At, B0); PG8_MMA(0, 1, At, B1); PG8_BAR; PG8_SCHED;
            PG8_LDA(At, 0, 1); PG8_STAGE(PG8_SB(0, 0), b2, voffB); PG8_STAGE(PG8_SB(0, 1), b2 + hstep, voffB); PG8_STAGE(PG8_SA(0, 0), a2, o2[0]);
            PG8_WAIT_V(8); PG8_WAIT_L(0); PG8_BAR; PG8_MMA(1, 0, At, B0); PG8_MMA(1, 1, At, B1); PG8_BAR; PG8_SCHED;
            PG8_LDB(B0, 1, 0); PG8_LDB(B1, 1, 1); PG8_SCHED; PG8_LDA(At, 1, 0); PG8_STAGE(PG8_SA(0, 1), a2, o2[1]);
            PG8_WAIT_V(8); PG8_WAIT_L(0); PG8_BAR; PG8_MMA(0, 0, At, B0); PG8_MMA(0, 1, At, B1); PG8_BAR; PG8_SCHED;
            PG8_LDA(At, 1, 1); PG8_STAGE(PG8_SB(1, 0), b3, voffB); PG8_STAGE(PG8_SB(1, 1), b3 + hstep, voffB); PG8_STAGE(PG8_SA(1, 0), a3, o2[0]);
            PG8_WAIT_V(8); PG8_WAIT_L(0); PG8_BAR; PG8_MMA(1, 0, At, B0); PG8_MMA(1, 1, At, B1); PG8_BAR; PG8_SCHED;
        }
        if (wr == 0) PG8_BAR;
        if constexpr (FP8) asm volatile("s_nop 15\n\ts_nop 7" ::: "memory");
        E(acc, cur, wr, wc, fr, fq);
        if (!has_next) break;
#pragma unroll
        for (int a = 0; a < 2; ++a)
#pragma unroll
            for (int b = 0; b < 2; ++b)
#pragma unroll
                for (int m = 0; m < 4; ++m)
#pragma unroll
                    for (int n = 0; n < 2; ++n) { acc[a][b][m][n] = (f32x4){0.f, 0.f, 0.f, 0.f}; asm volatile("" : "+v"(acc[a][b][m][n])); }
        cur = nxt; cA = nA; cB = nB; ++ui;
#pragma unroll
        for (int h = 0; h < 2; ++h)
#pragma unroll
            for (int i = 0; i < 2; ++i) offA[h][i] = offAn[h][i];
        if (wr == 1) PG8_BAR;
    }
    PG8_WAIT_V(0);
    PG8_BAR;
#undef PG8_SA
#undef PG8_SB
#undef PG8_STAGE
#undef PG8_LDA
#undef PG8_LDB
#undef PG8_MMA
#undef PG8_CAT8
#undef PG8_LD8
#undef PG8_WAIT_V
#undef PG8_WAIT_L
#undef PG8_BAR
#undef PG8_SCHED
#undef PG8_AOFFS
}
}
namespace attn_body {
using bf16x8=__attribute__((ext_vector_type(8)))short;
using s16x4=__attribute__((ext_vector_type(4)))short;
using f32x16=__attribute__((ext_vector_type(16)))float;
using u32x4=__attribute__((ext_vector_type(4)))unsigned;
typedef unsigned short bf16;
constexpr int NHEAD=8,SEQ=4096,D=64;
constexpr int PQ=512,PK=512,PO=512;
constexpr int NW=8,QBLK=32,QB=QBLK*NW,KVBLK=64;
__device__ __forceinline__ int crow(int r,int hi){return (r&3)+8*(r>>2)+4*hi;}
#define SBAR() __builtin_amdgcn_sched_barrier(0)
constexpr int NSLOT=3, SLOTB=8192;
constexpr int LDS_K=0, LDS_V=NSLOT*SLOTB, LDS_WS=2*NSLOT*SLOTB, LDS_OST=LDS_WS+NW*64*4, LDS_BYTES=LDS_OST+NW*4096;
__device__ __forceinline__ void glds16(const void*gsrc,unsigned lds_dst){unsigned keep;
  asm volatile("s_mov_b32 %0, m0\n\ts_mov_b32 m0, %2\n\ts_nop 0\n\tglobal_load_lds_dwordx4 %1, off\n\ts_mov_b32 m0, %0":"=&s"(keep):"v"(gsrc),"s"(lds_dst):"memory");}
typedef float f32x2_t __attribute__((ext_vector_type(2))); typedef __bf16 bf16x2_t __attribute__((ext_vector_type(2)));
__device__ __forceinline__ unsigned cvtpk_s(float lo,float hi){f32x2_t v={lo,hi};bf16x2_t b=__builtin_convertvector(v,bf16x2_t);return __builtin_bit_cast(unsigned,b);}
#define WAIT_BAR(N) asm volatile("s_waitcnt vmcnt(" #N ") lgkmcnt(0)\n\ts_barrier":::"memory")
#define WAIT_BAR_M(N,M) asm volatile("s_waitcnt vmcnt(" #N ") lgkmcnt(0)\n\ts_barrier":"+v"(M)::"memory")

__device__ __forceinline__ void qkt(f32x16&p0,f32x16&p1,const char*Kslot,const bf16x8*qr,int r32,int hi){
  const f32x16 negm={};
  const char*kb=Kslot+hi*1024+r32*16;
  #pragma unroll
  for(int d0=0;d0<4;++d0){
    const bf16x8 b0=*reinterpret_cast<const bf16x8*>(kb+d0*2048);
    const bf16x8 b1=*reinterpret_cast<const bf16x8*>(kb+d0*2048+512);
    if(d0==0){p0=__builtin_amdgcn_mfma_f32_32x32x16_bf16(b0,qr[0],negm,0,0,0);p1=__builtin_amdgcn_mfma_f32_32x32x16_bf16(b1,qr[0],negm,0,0,0);}
    else{p0=__builtin_amdgcn_mfma_f32_32x32x16_bf16(b0,qr[d0],p0,0,0,0);p1=__builtin_amdgcn_mfma_f32_32x32x16_bf16(b1,qr[d0],p1,0,0,0);}}
}
typedef __attribute__((address_space(3))) const char* lds_cptr;
typedef short v4i16_t __attribute__((ext_vector_type(4)));
__device__ __forceinline__ void kload8(bf16x8*kf,lds_cptr kp){
  kf[0]=*(const __attribute__((address_space(3))) bf16x8*)(kp);      kf[1]=*(const __attribute__((address_space(3))) bf16x8*)(kp+512);
  kf[2]=*(const __attribute__((address_space(3))) bf16x8*)(kp+2048); kf[3]=*(const __attribute__((address_space(3))) bf16x8*)(kp+2560);
  kf[4]=*(const __attribute__((address_space(3))) bf16x8*)(kp+4096); kf[5]=*(const __attribute__((address_space(3))) bf16x8*)(kp+4608);
  kf[6]=*(const __attribute__((address_space(3))) bf16x8*)(kp+6144); kf[7]=*(const __attribute__((address_space(3))) bf16x8*)(kp+6656);
}
__device__ __forceinline__ void kload2(bf16x8*kf,lds_cptr kp,int j){ kf[2*j]=*(const __attribute__((address_space(3))) bf16x8*)(kp+j*2048); kf[2*j+1]=*(const __attribute__((address_space(3))) bf16x8*)(kp+j*2048+512); }
__device__ __forceinline__ s16x4 vtr(lds_cptr p){ return __builtin_bit_cast(s16x4,__builtin_amdgcn_ds_read_tr16_b64_v4i16((__attribute__((address_space(3))) v4i16_t*)p)); }
__device__ __forceinline__ void pv(f32x16*o,int vb,bf16x8 pa0,bf16x8 pa1,bf16x8 pa2,bf16x8 pa3){
  #pragma unroll
  for(int d0=0;d0<2;++d0){s16x4 lo[4],hi[4];
    #pragma unroll
    for(int ks=0;ks<4;++ks){
      asm volatile("ds_read_b64_tr_b16 %0,%1 offset:%c2":"=&v"(lo[ks]):"v"(vb),"i"(d0*4096+ks*1024):"memory");
      asm volatile("ds_read_b64_tr_b16 %0,%1 offset:%c2":"=&v"(hi[ks]):"v"(vb),"i"(d0*4096+ks*1024+512):"memory");}
    asm volatile("s_waitcnt lgkmcnt(0)":::"memory");SBAR();
    #define PK(k) (bf16x8){lo[k][0],lo[k][1],lo[k][2],lo[k][3],hi[k][0],hi[k][1],hi[k][2],hi[k][3]}
    o[d0]=__builtin_amdgcn_mfma_f32_32x32x16_bf16(pa0,PK(0),o[d0],0,0,0);
    o[d0]=__builtin_amdgcn_mfma_f32_32x32x16_bf16(pa1,PK(1),o[d0],0,0,0);
    o[d0]=__builtin_amdgcn_mfma_f32_32x32x16_bf16(pa2,PK(2),o[d0],0,0,0);
    o[d0]=__builtin_amdgcn_mfma_f32_32x32x16_bf16(pa3,PK(3),o[d0],0,0,0);
    #undef PK
  }
}
#define MBIT(W,r) ((unsigned)__builtin_amdgcn_sbfe((int)(W),(unsigned)(((r)&3)+8*((r)>>2)),1u))
#define MEXP(X,r,W) X[r]=__uint_as_float(__float_as_uint(__builtin_amdgcn_exp2f(X[r]))&MBIT(W,r))
typedef unsigned long long u64;
__device__ __forceinline__ void attn_unit(int b,int h,int qb,const bf16*Q,const bf16*__restrict__ K,const bf16*__restrict__ V,int PV_,bf16*O,const u64*MASK,char*shm){
  int tid_=threadIdx.x; asm volatile("":"+v"(tid_)); const int tid=tid_,lane=tid&63,r32=lane&31,hi=lane>>5; const int wid=__builtin_amdgcn_readfirstlane(tid>>6);
  const long rowbase=(long)b*SEQ; const int q0=qb*QB;
  const bf16*Qw=Q+(rowbase+q0+wid*QBLK)*PQ+h*D;
  const bf16*Kh=K+rowbase*PK+h*D,*Vh=V+rowbase*PV_+h*D;
  const unsigned lds0=(unsigned)(uintptr_t)shm;
  float*wsf=(float*)(shm+LDS_WS)+wid*64;
  const bf16*ksrc=Kh+(long)lane*PK+wid*8;
  const bf16*vsrc=Vh+(long)(16*(wid&3)+(lane>>2))*PV_+(wid>>2)*32+(lane&3)*8;
  const unsigned kdst=lds0+LDS_K+wid*1024, vdst=lds0+LDS_V+wid*1024;
  #define DMA_K(t,slot) glds16(ksrc+(long)(t)*KVBLK*PK,(unsigned)__builtin_amdgcn_readfirstlane(kdst+(slot)))
  #define DMA_V(t,slot) glds16(vsrc+(long)(t)*KVBLK*PV_,(unsigned)__builtin_amdgcn_readfirstlane(vdst+(slot)))
  const u64*mptr=MASK+((long)b*64*SEQ)+(q0+wid*QBLK+r32);
  #define MLOAD(dst,t) dst=mptr[(long)(t)*SEQ]
  const int vb0=(int)(lds0+LDS_V)+((lane>>4)&1)*32+(lane&3)*8+(4*hi+((lane&15)>>2))*64;
  const char*Kbase=shm+LDS_K; bf16x8 kf[8];
  const lds_cptr shm3=(lds_cptr)shm; const lds_cptr kp0=shm3+LDS_K+hi*1024+r32*16; const lds_cptr vp0=shm3+LDS_V+((lane>>4)&1)*32+(lane&3)*8+(4*hi+((lane&15)>>2))*64;
  const int NT=(q0+QB)/KVBLK;
  u64 mA,mB;
  MLOAD(mA,0);
  DMA_K(0,0);DMA_V(0,0);DMA_K(1,SLOTB);
  bf16x8 qr[4];
  #pragma unroll
  for(int d0=0;d0<4;++d0)qr[d0]=*reinterpret_cast<const bf16x8*>(&Qw[(long)r32*PQ+d0*16+hi*8]);
  float l_reg=0.f;f32x16 o[2];o[0]=f32x16{};o[1]=f32x16{};const f32x16 negm={};
  const int msh=4*hi;
  f32x16 pA0,pA1,pB0,pB1;
  int sl_prev=0,sl_cur=0,sl_next=SLOTB;
  #define ROT() do{sl_prev=sl_cur;sl_cur=sl_next;sl_next=(sl_next==(NSLOT-1)*SLOTB)?0:sl_next+SLOTB;}while(0)
  DMA_K(2,2*SLOTB);
  WAIT_BAR(3);
  qkt(pA0,pA1,Kbase,qr,r32,hi);asm volatile("s_nop 15\n\ts_nop 7":"+v"(pA0),"+v"(pA1));
  { const unsigned w0=(unsigned)mA>>msh, w1=(unsigned)(mA>>32)>>msh;
    _Pragma("unroll") for(int r=0;r<16;++r){ MEXP(pA0,r,w0); MEXP(pA1,r,w1); } }
  WAIT_BAR(0);
  MLOAD(mB,1);
  DMA_K(3,0);DMA_V(1,SLOTB);
  ROT();
  kload8(kf,kp0+sl_cur);
  WAIT_BAR(2);
  s16x4 vlo[8],vhi[8]; u32x4 pw0,pw1,pw2,pw3;
  #define PKW(P,B) cvtpk_s(P[B],P[B+1])
  #define PAF(k) __builtin_bit_cast(bf16x8,pw##k)
  #define VFR(i) (bf16x8){vlo[i][0],vlo[i][1],vlo[i][2],vlo[i][3],vhi[i][0],vhi[i][1],vhi[i][2],vhi[i][3]}
  #define PIN(x) asm volatile("":"+v"(x))
  #define GAPA(MF,A0,A1,A2,A3,W0,W1,PW) do{ MF; sacc+=A0; sacc+=A1; sacc+=A2; sacc+=A3; PIN(sacc); W0; W1; PIN(PW); SBAR(); }while(0)
  #define GAPB(MF,X,B,W) do{ MF; MEXP(X,B,W); MEXP(X,B+1,W); MEXP(X,B+2,W); MEXP(X,B+3,W); PIN(X); SBAR(); }while(0)
  #define VRD(i) do{ vlo[i]=vtr(vp_+(((i)>>2)*4096+((i)&3)*1024)); vhi[i]=vtr(vp_+(((i)>>2)*4096+((i)&3)*1024+512)); }while(0)
  #define KRD(G,j) do{ if(G){ kload2(kf,kp0+sl_next,j); SBAR(); } }while(0)
  #define STEP(C0,C1,P0,P1,t,GK,GV,GL,MC,MN,GM) do{ SBAR(); \
    unsigned w0_=(unsigned)(MC)>>msh, w1_=(unsigned)((MC)>>32)>>msh; asm volatile("":"+v"(w0_),"+v"(w1_)); \
    if(GM){MLOAD(MN,(t)+1);} if(GK){DMA_K((t)+3,sl_cur);} if(GV){DMA_V((t)+1,sl_next);} SBAR(); \
    const lds_cptr vp_=vp0+sl_prev; \
    VRD(0); SBAR(); float sacc=(P0[0]+P0[1]); \
    GAPA(C0=__builtin_amdgcn_mfma_f32_32x32x16_bf16(kf[0],qr[0],negm,0,0,0), P0[2],P0[3],P0[4],P0[5],     pw0[0]=PKW(P0,0), pw0[1]=PKW(P0,2), pw0); \
    VRD(4); SBAR(); GAPA(C1=__builtin_amdgcn_mfma_f32_32x32x16_bf16(kf[1],qr[0],negm,0,0,0), P0[6],P0[7],P0[8],P0[9],     pw0[2]=PKW(P0,4), pw0[3]=PKW(P0,6), pw0); \
    VRD(1); SBAR(); GAPA(C0=__builtin_amdgcn_mfma_f32_32x32x16_bf16(kf[2],qr[1],C0,0,0,0),   P0[10],P0[11],P0[12],P0[13], pw1[0]=PKW(P0,8), pw1[1]=PKW(P0,10), pw1); \
    VRD(5); SBAR(); GAPA(C1=__builtin_amdgcn_mfma_f32_32x32x16_bf16(kf[3],qr[1],C1,0,0,0),   P0[14],P0[15],P1[0],P1[1],   pw1[2]=PKW(P0,12),pw1[3]=PKW(P0,14), pw1); \
    VRD(2); SBAR(); GAPA(C0=__builtin_amdgcn_mfma_f32_32x32x16_bf16(kf[4],qr[2],C0,0,0,0),   P1[2],P1[3],P1[4],P1[5],     pw2[0]=PKW(P1,0), pw2[1]=PKW(P1,2), pw2); \
    VRD(6); SBAR(); GAPA(C1=__builtin_amdgcn_mfma_f32_32x32x16_bf16(kf[5],qr[2],C1,0,0,0),   P1[6],P1[7],P1[8],P1[9],     pw2[2]=PKW(P1,4), pw2[3]=PKW(P1,6), pw2); \
    VRD(3); SBAR(); GAPA(C0=__builtin_amdgcn_mfma_f32_32x32x16_bf16(kf[6],qr[3],C0,0,0,0),   P1[10],P1[11],P1[12],P1[13], pw3[0]=PKW(P1,8), pw3[1]=PKW(P1,10), pw3); \
    VRD(7); SBAR(); GAPA(C1=__builtin_amdgcn_mfma_f32_32x32x16_bf16(kf[7],qr[3],C1,0,0,0),   P1[14],P1[15],0.f,0.f,       pw3[2]=PKW(P1,12),pw3[3]=PKW(P1,14), pw3); \
    l_reg+=sacc; \
    SBAR(); \
    GAPB(o[0]=__builtin_amdgcn_mfma_f32_32x32x16_bf16(PAF(0),VFR(0),o[0],0,0,0), C0,0,w0_); \
    GAPB(o[1]=__builtin_amdgcn_mfma_f32_32x32x16_bf16(PAF(0),VFR(4),o[1],0,0,0), C0,4,w0_); \
    KRD(GL,0); GAPB(o[0]=__builtin_amdgcn_mfma_f32_32x32x16_bf16(PAF(1),VFR(1),o[0],0,0,0), C0,8,w0_); \
    KRD(GL,1); GAPB(o[1]=__builtin_amdgcn_mfma_f32_32x32x16_bf16(PAF(1),VFR(5),o[1],0,0,0), C0,12,w0_); \
    KRD(GL,2); GAPB(o[0]=__builtin_amdgcn_mfma_f32_32x32x16_bf16(PAF(2),VFR(2),o[0],0,0,0), C1,0,w1_); \
    KRD(GL,3); GAPB(o[1]=__builtin_amdgcn_mfma_f32_32x32x16_bf16(PAF(2),VFR(6),o[1],0,0,0), C1,4,w1_); \
    GAPB(o[0]=__builtin_amdgcn_mfma_f32_32x32x16_bf16(PAF(3),VFR(3),o[0],0,0,0), C1,8,w1_); \
    GAPB(o[1]=__builtin_amdgcn_mfma_f32_32x32x16_bf16(PAF(3),VFR(7),o[1],0,0,0), C1,12,w1_); \
    }while(0)
  int t=1;
  for(;t+5<NT;t+=2){
    STEP(pB0,pB1,pA0,pA1,t,true,true,true,mB,mA,true);     WAIT_BAR(2); ROT();
    STEP(pA0,pA1,pB0,pB1,t+1,true,true,true,mA,mB,true);   WAIT_BAR(2); ROT();
  }
  #define ENDW(tt,M) do{ if((tt)+3<NT){WAIT_BAR(2);} else if((tt)+2<NT){WAIT_BAR(1);} else {WAIT_BAR(0);} }while(0)
  for(;t+1<NT;t+=2){
    STEP(pB0,pB1,pA0,pA1,t,(t+3<NT),(t+1<NT),(t+1<NT),mB,mA,(t+1<NT));       ENDW(t,mA);   ROT();
    STEP(pA0,pA1,pB0,pB1,t+1,(t+4<NT),(t+2<NT),(t+2<NT),mA,mB,(t+2<NT));     ENDW(t+1,mB); ROT();
  }
  STEP(pB0,pB1,pA0,pA1,NT-1,false,false,false,mB,mA,false);
  { float sacc=pB0[0]+pB0[1]; _Pragma("unroll") for(int r=2;r<16;++r)sacc+=pB0[r]; _Pragma("unroll") for(int r=0;r<16;++r)sacc+=pB1[r]; l_reg+=sacc;
    pw0=(u32x4){PKW(pB0,0),PKW(pB0,2),PKW(pB0,4),PKW(pB0,6)};pw1=(u32x4){PKW(pB0,8),PKW(pB0,10),PKW(pB0,12),PKW(pB0,14)};pw2=(u32x4){PKW(pB1,0),PKW(pB1,2),PKW(pB1,4),PKW(pB1,6)};pw3=(u32x4){PKW(pB1,8),PKW(pB1,10),PKW(pB1,12),PKW(pB1,14)};
    SBAR(); pv(o,vb0+sl_cur,PAF(0),PAF(1),PAF(2),PAF(3)); }
  #undef PKW
  #undef PAF
  #undef VFR
  #undef PIN
  #undef GAPA
  #undef GAPB
  #undef VRD
  #undef KRD
  #undef STEP
  #undef ENDW
  {auto rr=__builtin_amdgcn_permlane32_swap(__float_as_uint(l_reg),__float_as_uint(l_reg),false,false);l_reg=__uint_as_float(rr[0])+__uint_as_float(rr[1]);}
  if(hi==0)wsf[32+r32]=l_reg;asm volatile("s_waitcnt lgkmcnt(0)":::"memory");
  float rli[16];
  #pragma unroll
  for(int r=0;r<16;++r)rli[r]=__builtin_amdgcn_rcpf(wsf[32+crow(r,hi)]);
  bf16*Ow=O+(rowbase+q0+wid*QBLK)*PO+h*D;
  { bf16*stg=(bf16*)(shm+LDS_OST)+wid*2048;
    #pragma unroll
    for(int r=0;r<16;++r){const int orow=crow(r,hi);
      #pragma unroll
      for(int d0=0;d0<2;++d0){ const unsigned pk=cvtpk_s(o[d0][r]*rli[r],0.f); stg[orow*64+d0*32+r32]=(bf16)(pk&0xffffu); } }
    asm volatile("s_waitcnt lgkmcnt(0)":::"memory");
    #pragma unroll
    for(int i=0;i<4;++i){const int row=i*8+(lane>>3),ch=lane&7; const u32x4 v=*(const u32x4*)(stg+row*64+ch*8); *(u32x4*)(Ow+(long)row*PO+ch*8)=v;} }
  asm volatile("s_waitcnt lgkmcnt(0)\n\ts_barrier":::"memory");
  #undef DMA_K
  #undef DMA_V
  #undef MLOAD
  #undef ROT
}
constexpr int ATTN_LDS_BYTES=LDS_BYTES;
#undef SBAR
#undef WAIT_BAR
#undef WAIT_BAR_M
#undef MBIT
#undef MEXP
}
constexpr int NWAVES = 8;
constexpr int N_LAUNCHES = MK_N_LAUNCHES;
constexpr int N_PHASES = 11;

constexpr int DMODEL = 1024, NBATCH = 4, SEQL = 4096, MTOK = NBATCH * SEQL;
constexpr int INW = 5444, ZW = 5632;
constexpr int ZC_XIN = 0, ZC_GB = 512, ZC_GC = 1024, ZC_Q = 1536, ZC_K = 2048, ZC_V = 2560, ZC_GA = 3072, ZC_GBR = 4096, ZC_QI = 5120, ZC_KI = 5376, ZC_WI = 5440;
constexpr int NEXP = 32, DFF = 1024;
constexpr int MAXSLOT = 65536 + NEXP * 256, MAXTILES = MAXSLOT / 256;
constexpr float EPSN = 1e-6f;
constexpr float C2 = 0.125f * 1.4426950408889634f;

constexpr size_t MiB = 1u << 20;
constexpr size_t WS_CTL = 0, CTL_ZERO_BYTES = 1 * MiB;
constexpr size_t WS_WIN = 2 * MiB;
constexpr size_t WS_PAB = 14 * MiB;
constexpr size_t WS_WO = 16 * MiB;
constexpr size_t WS_WGU = 18 * MiB;
constexpr size_t WS_WD = 146 * MiB;
constexpr size_t WS_H = 210 * MiB;
constexpr size_t WS_Z = 242 * MiB;
constexpr size_t WS_ACT = WS_Z;
constexpr size_t WS_QN = 418 * MiB, WS_KN = 434 * MiB;
constexpr size_t WS_YAB = 450 * MiB;
constexpr size_t WS_MASK = 482 * MiB;
constexpr size_t WS_MRG = 490 * MiB;
constexpr size_t WS_YBUF = 522 * MiB;
constexpr size_t WS_LIST = 666 * MiB;
constexpr size_t WS_TOKER = 668 * MiB;
constexpr size_t WS_TOKG = 669 * MiB;
constexpr size_t WS_H8 = 670 * MiB;
constexpr size_t WS_END = 686 * MiB;
#ifndef MOE_FP8
#define MOE_FP8 1
#endif
constexpr float W8_SCALE = 64.0f; constexpr int W8_SCALE_E8M0 = 0x79797979, ONE_E8M0 = 0x7f7f7f7f;
constexpr int CW_BAR = 4096;
constexpr int CW_ECNT_BASE = 8192;
#ifndef PH_DOUBLE
#define PH_DOUBLE 0
#endif
constexpr int CW_ECNT = CW_ECNT_BASE + 32 * ((PH_DOUBLE >> 7) & 1);
constexpr int CW_MOD = 16384;

constexpr int RING_OFF = 0, RING_BYTES = 131072;
constexpr int LDSCTL_OFF = RING_BYTES, MISC_OFF = LDSCTL_OFF + 320, TAB_OFF = LDSCTL_OFF + 1024;
constexpr int LDS_BYTES = 147456;

#define GAS __attribute__((address_space(1)))
#define LAS __attribute__((address_space(3)))
typedef unsigned short bf16;
typedef unsigned v4u __attribute__((ext_vector_type(4)));
typedef float f32x4 __attribute__((ext_vector_type(4)));
typedef float f32x2 __attribute__((ext_vector_type(2)));
typedef float f32x16 __attribute__((ext_vector_type(16)));
typedef short bf16x8 __attribute__((ext_vector_type(8)));
typedef unsigned long long u64;
#define RLX_AGENT __ATOMIC_RELAXED, __HIP_MEMORY_SCOPE_AGENT
#define LDS_WAIT() asm volatile("s_waitcnt lgkmcnt(0)" ::: "memory")
#define VM_WAIT() asm volatile("s_waitcnt vmcnt(0)" ::: "memory")
__device__ __forceinline__ unsigned pkbf(float lo, float hi) { return pg8::cvt_pk_bf16(lo, hi); }
__device__ __forceinline__ float bflo(unsigned w) { return __uint_as_float(w << 16); }
__device__ __forceinline__ float bfhi(unsigned w) { return __uint_as_float(w & 0xffff0000u); }
__device__ __forceinline__ float bf2f(bf16 h) { return __uint_as_float((unsigned)h << 16); }
__device__ __forceinline__ float wave_sum(float v) {
#pragma unroll
    for (int o = 1; o < 64; o <<= 1) v += __shfl_xor(v, o);
    return v;
}
__device__ __forceinline__ float wave_max(float v) {
#pragma unroll
    for (int o = 1; o < 64; o <<= 1) v = fmaxf(v, __shfl_xor(v, o));
    return v;
}

#define XB_TMO      128
#define XB_XCNT(j)  (256  + 64 * (j))
#define XB_XSUB(j)  (1280 + 64 * (j))
#define XB_XGEN(j)  (2304 + 64 * (j))
#define XB_TOP      3328
#define XB_TOPGEN   3392
#define XCD_BAR_WORDS 3456
#define XB_SPIN_CAP (1u << 18)
__device__ __forceinline__ unsigned xb_ld(unsigned* p)              { return __hip_atomic_load(p, __ATOMIC_RELAXED, __HIP_MEMORY_SCOPE_AGENT); }
__device__ __forceinline__ unsigned xb_add(unsigned* p, unsigned v) { return __hip_atomic_fetch_add(p, v, __ATOMIC_RELAXED, __HIP_MEMORY_SCOPE_AGENT); }
__device__ __forceinline__ unsigned xb_xcc_id() { return (unsigned)__builtin_amdgcn_s_getreg((3 << 11) | 20) & 0xFu; }
#define XB_SPIN(cond, bar) do { unsigned _sp = 0; while (cond) { __builtin_amdgcn_s_sleep(1); \
    if ((++_sp & 255u) == 0u) { if (xb_ld(&(bar)[XB_TMO])) break; if (_sp > XB_SPIN_CAP) { atomicAdd(&(bar)[XB_TMO], 1u); break; } } } } while (0)
struct XcdBarrier { unsigned* bar; unsigned x; volatile LAS unsigned* st; };
__device__ __forceinline__ XcdBarrier xcd_barrier_post(unsigned* bar, volatile LAS unsigned* st) {
    XcdBarrier b; b.bar = bar; b.x = xb_xcc_id(); b.st = st;
    if (threadIdx.x == 0) (void)xb_add(&bar[XB_XCNT(b.x)], 1u);
    return b;
}
__device__ __forceinline__ void xcd_barrier_complete(unsigned* bar, unsigned x, unsigned& nloc, unsigned& nx) {
    const unsigned G = gridDim.x * gridDim.y * gridDim.z;
    unsigned sum, cnt, mine, sp = 0u;
    for (;;) {
        sum = 0u; cnt = 0u; mine = 0u;
#pragma unroll
        for (unsigned j = 0; j < 16; ++j) { const unsigned c = xb_ld(&bar[XB_XCNT(j)]); sum += c; cnt += (c > 0u) ? 1u : 0u; mine = (j == x) ? c : mine; }
        if (sum == G) break;
        __builtin_amdgcn_s_sleep(1);
        if ((++sp & 255u) == 0u) { if (xb_ld(&bar[XB_TMO])) break; if (sp > XB_SPIN_CAP) { atomicAdd(&bar[XB_TMO], 1u); break; } }
    }
    nloc = mine > 0u ? mine : 1u; nx = cnt > 0u ? cnt : 1u;
}
__device__ __forceinline__ void xcd_barrier(const XcdBarrier& b) {
    asm volatile("s_waitcnt vmcnt(0)" ::: "memory");
    __syncthreads();
    if (threadIdx.x == 0) {
        unsigned* bar = b.bar;
        __builtin_amdgcn_s_waitcnt(0);
        unsigned nloc = b.st[0], nx = b.st[1];
        if (nloc == 0u) { xcd_barrier_complete(bar, b.x, nloc, nx); b.st[0] = nloc; b.st[1] = nx; }
        const unsigned old = xb_add(&bar[XB_XSUB(b.x)], 1u);
        const unsigned gen = old / nloc;
        if (old + 1u == (gen + 1u) * nloc) {
            __builtin_amdgcn_fence(__ATOMIC_RELEASE, "agent");
            asm volatile("s_waitcnt vmcnt(0)" ::: "memory");
            const unsigned og = xb_add(&bar[XB_TOP], 1u);
            const unsigned tg = og / nx;
            if (og + 1u == (tg + 1u) * nx) xb_add(&bar[XB_TOPGEN], 1u);
            else XB_SPIN(xb_ld(&bar[XB_TOPGEN]) == tg, bar);
            __builtin_amdgcn_fence(__ATOMIC_ACQUIRE, "agent");
            xb_add(&bar[XB_XGEN(b.x)], 1u);
            asm volatile("s_waitcnt vmcnt(0)" ::: "memory");
        } else {
            XB_SPIN(xb_ld(&bar[XB_XGEN(b.x)]) == gen, bar);
            __builtin_amdgcn_fence(__ATOMIC_ACQUIRE, "agent");
            asm volatile("s_waitcnt vmcnt(0)" ::: "memory");
        }
    }
    __syncthreads();
}

struct Args { const float* in[19]; float* out; unsigned char* ws; int ph_lo, ph_hi; };
typedef const __attribute__((address_space(4))) Args* kargs_t;
typedef const float* cfptr_t; typedef const __attribute__((address_space(4))) cfptr_t* inarr_t;
__device__ __forceinline__ kargs_t kargs() {
#if defined(__HIP_DEVICE_COMPILE__)
    unsigned long long v = (unsigned long long)__builtin_amdgcn_kernarg_segment_ptr(); asm volatile("" : "+s"(v)); return (kargs_t)v;
#else
    return (kargs_t)0;
#endif
}
struct Frame {
    LAS unsigned char* lds;
    volatile LAS unsigned* MISC;
    int tid, lane, wave, vcu, G, bx;
};
enum { I_X = 0, I_C, I_WADA, I_BADA, I_N1G, I_WIN, I_CONVW, I_QNG, I_KNG, I_WCO, I_WAO, I_WO, I_N2G, I_WR, I_BR, I_WGU, I_BGU, I_WD, I_BD };

__device__ __forceinline__ void ph_adaln(Frame& F) {
    { int t_ = threadIdx.x; asm volatile("" : "+v"(t_)); F.tid = t_; F.lane = t_ & 63; F.wave = __builtin_amdgcn_readfirstlane(t_ >> 6); }
    kargs_t ap = kargs(); inarr_t IN = (inarr_t)ap->in; unsigned char* WS = ap->ws; unsigned* CTL = (unsigned*)(WS + WS_CTL); float* OUT = ap->out; (void)IN; (void)OUT; (void)CTL;
    float* mod = (float*)(CTL + CW_MOD);
    const float* c = IN[I_C]; const float* W = IN[I_WADA]; const float* ba = IN[I_BADA];
    const int gw = F.vcu * NWAVES + F.wave, NGW = F.G * NWAVES;
    for (int it = gw; it < 1536; it += NGW) {
        const int c0 = 4 * it;
        f32x4 acc[4];
#pragma unroll
        for (int b = 0; b < 4; ++b) acc[b] = (f32x4){0.f, 0.f, 0.f, 0.f};
#pragma unroll 4
        for (int i = 0; i < 16; ++i) {
            const int k = 64 * i + F.lane;
            const f32x4 w = *(const f32x4*)(W + (size_t)k * 6144 + c0);
#pragma unroll
            for (int b = 0; b < 4; ++b) { const float cv = c[b * 1024 + k]; const float s = cv * pg8::fast_sigmoid(cv); acc[b] += w * s; }
        }
#pragma unroll
        for (int b = 0; b < 4; ++b) {
            const float a0 = wave_sum(acc[b].x), a1 = wave_sum(acc[b].y), a2 = wave_sum(acc[b].z), a3 = wave_sum(acc[b].w);
            if (F.lane == 0) *(f32x4*)(mod + b * 6144 + c0) = (f32x4){a0 + ba[c0], a1 + ba[c0 + 1], a2 + ba[c0 + 2], a3 + ba[c0 + 3]};
        }
    }
}

__device__ __forceinline__ void tr_item(const float* src, int ldw, int nvalid, bf16* dst, int K, int lane) {
    const int kc = lane >> 3, ng = lane & 7;
    f32x4 v[8];
    const bool ok = 4 * ng < nvalid;
#pragma unroll
    for (int i = 0; i < 8; ++i) v[i] = ok ? *(const f32x4*)(src + (size_t)(8 * kc + i) * ldw + 4 * ng) : (f32x4){0.f, 0.f, 0.f, 0.f};
#pragma unroll
    for (int j = 0; j < 4; ++j) {
        v4u o; o.x = pkbf(v[0][j], v[1][j]); o.y = pkbf(v[2][j], v[3][j]); o.z = pkbf(v[4][j], v[5][j]); o.w = pkbf(v[6][j], v[7][j]);
        *(v4u*)(dst + (size_t)(4 * ng + j) * K + 8 * kc) = o;
    }
}
__device__ __forceinline__ void tr_item8(const float* src, int ldw, unsigned char* dst, int K, int lane, float scale) {
    const int kc = lane >> 3, ng = lane & 7;
    f32x4 v[8];
#pragma unroll
    for (int i = 0; i < 8; ++i) v[i] = *(const f32x4*)(src + (size_t)(8 * kc + i) * ldw + 4 * ng) * scale;
#pragma unroll
    for (int j = 0; j < 4; ++j) {
        f32x2 dummy; (void)dummy;
        const unsigned lo = pg8::pk4_fp8(v[0][j], v[1][j], v[2][j], v[3][j]), hi = pg8::pk4_fp8(v[4][j], v[5][j], v[6][j], v[7][j]);
        *(u64*)(dst + (size_t)(4 * ng + j) * K + 8 * kc) = (u64)lo | ((u64)hi << 32);
    }
}
__device__ __forceinline__ void norm_row_to_bf16(const float* xrow, const float* g, const float* sc, const float* sh, bf16* orow, int lane) {
    const f32x4* xr = (const f32x4*)xrow + lane;
    f32x4 v[4]; float s = 0.f;
#pragma unroll
    for (int j = 0; j < 4; ++j) { v[j] = xr[64 * j]; s += (v[j].x * v[j].x + v[j].y * v[j].y) + (v[j].z * v[j].z + v[j].w * v[j].w); }
    const float rstd = 1.0f / sqrtf(wave_sum(s) * (1.f / 1024.f) + EPSN);
    u64* o8 = (u64*)orow + lane;
#pragma unroll
    for (int j = 0; j < 4; ++j) {
        const f32x4 gv = ((const f32x4*)g)[lane + 64 * j], scv = ((const f32x4*)sc)[lane + 64 * j], shv = ((const f32x4*)sh)[lane + 64 * j];
        const f32x4 y = (v[j] * rstd) * gv * (scv + 1.0f) + shv;
        o8[64 * j] = (u64)pkbf(y.x, y.y) | ((u64)pkbf(y.z, y.w) << 32);
    }
}
__device__ __forceinline__ void ph_prologue(Frame& F) {
    { int t_ = threadIdx.x; asm volatile("" : "+v"(t_)); F.tid = t_; F.lane = t_ & 63; F.wave = __builtin_amdgcn_readfirstlane(t_ >> 6); }
    kargs_t ap = kargs(); inarr_t IN = (inarr_t)ap->in; unsigned char* WS = ap->ws; unsigned* CTL = (unsigned*)(WS + WS_CTL); float* OUT = ap->out; (void)IN; (void)OUT; (void)CTL;
    const int gw = F.vcu * NWAVES + F.wave, NGW = F.G * NWAVES;
    bf16* Win_t = (bf16*)(WS + WS_WIN); bf16* Pab_t = (bf16*)(WS + WS_PAB); bf16* Wo_t = (bf16*)(WS + WS_WO); bf16* Wgu_t = (bf16*)(WS + WS_WGU); bf16* Wd_t = (bf16*)(WS + WS_WD);
    constexpr int I_IN = 16 * 176, I_PA = 8 * 32, I_PB = 8 * 32, I_O = 16 * 32, I_GU = 32 * 16 * 64, I_D = 32 * 16 * 32;
    constexpr int NITEMS = I_IN + I_PA + I_PB + I_O + I_GU + I_D;
    for (int it = gw; it < NITEMS; it += NGW) {
        int r = it;
        if (r < I_IN) { const int kb = r / 176, nb = r % 176, n0 = 32 * nb; int c0, nv;
            if (n0 < 3072) { c0 = n0; nv = 32; } else if (n0 < 5120) { c0 = n0 + 324; nv = 32; } else if (n0 < 5440) { c0 = n0 - 2048; nv = 32; } else if (n0 == 5440) { c0 = 3392; nv = 4; } else { c0 = 0; nv = 0; }
            tr_item(IN[I_WIN] + (size_t)(64 * kb) * INW + c0, INW, nv, Win_t + (size_t)n0 * 1024 + 64 * kb, 1024, F.lane); continue; } r -= I_IN;
        if (r < I_PA) { const int kb = r / 32, nb = r % 32; tr_item(IN[I_WCO] + (size_t)(64 * kb) * 1024 + 32 * nb, 1024, 32, Pab_t + (size_t)(32 * nb) * 512 + 64 * kb, 512, F.lane); continue; } r -= I_PA;
        if (r < I_PB) { const int kb = r / 32, nb = r % 32; tr_item(IN[I_WAO] + (size_t)(64 * kb) * 1024 + 32 * nb, 1024, 32, Pab_t + (size_t)(1024 + 32 * nb) * 512 + 64 * kb, 512, F.lane); continue; } r -= I_PB;
        if (r < I_O) { const int kb = r / 32, nb = r % 32; tr_item(IN[I_WO] + (size_t)(64 * kb) * 1024 + 32 * nb, 1024, 32, Wo_t + (size_t)(32 * nb) * 1024 + 64 * kb, 1024, F.lane); continue; } r -= I_O;
        if (r < I_GU) { const int e = r / 1024, q = r % 1024, kb = q / 64, nb = q % 64; const int cn = nb >> 3, bj = (nb >> 2) & 1, sub = nb & 3, c0 = 1024 * bj + 128 * cn + 32 * sub;
            if (MOE_FP8) tr_item8(IN[I_WGU] + ((size_t)e * 1024 + 64 * kb) * 2048 + c0, 2048, (unsigned char*)Wgu_t + ((size_t)e * 2048 + 32 * nb) * 1024 + 64 * kb, 1024, F.lane, W8_SCALE);
            else tr_item(IN[I_WGU] + ((size_t)e * 1024 + 64 * kb) * 2048 + c0, 2048, 32, Wgu_t + ((size_t)e * 2048 + 32 * nb) * 1024 + 64 * kb, 1024, F.lane); continue; } r -= I_GU;
        { const int e = r / 512, q = r % 512, kb = q / 32, nb = q % 32;
            if (MOE_FP8) tr_item8(IN[I_WD] + ((size_t)e * 1024 + 64 * kb) * 1024 + 32 * nb, 1024, (unsigned char*)Wd_t + ((size_t)e * 1024 + 32 * nb) * 1024 + 64 * kb, 1024, F.lane, W8_SCALE);
            else tr_item(IN[I_WD] + ((size_t)e * 1024 + 64 * kb) * 1024 + 32 * nb, 1024, 32, Wd_t + ((size_t)e * 1024 + 32 * nb) * 1024 + 64 * kb, 1024, F.lane); }
    }
    const float* mod = (const float*)(CTL + CW_MOD);
    bf16* H = (bf16*)(WS + WS_H);
    for (int m = gw; m < MTOK; m += NGW) { const float* mb = mod + (size_t)(m >> 12) * 6144;
        norm_row_to_bf16(IN[I_X] + (size_t)m * 1024, IN[I_N1G], mb + 1024, mb, H + (size_t)m * 1024, F.lane); }
}

__device__ __forceinline__ void sel_unit(Frame& F, int b, int j, int hf) {
    { int t_ = threadIdx.x; asm volatile("" : "+v"(t_)); F.tid = t_; F.lane = t_ & 63; F.wave = __builtin_amdgcn_readfirstlane(t_ >> 6); }
    kargs_t ap = kargs(); inarr_t IN = (inarr_t)ap->in; unsigned char* WS = ap->ws; unsigned* CTL = (unsigned*)(WS + WS_CTL); float* OUT = ap->out; (void)IN; (void)OUT; (void)CTL;
    LAS unsigned* hist = (LAS unsigned*)(F.lds);
    LAS unsigned* mgt = (LAS unsigned*)(F.lds + 32768);
    LAS unsigned* meq = (LAS unsigned*)(F.lds + 49152);
    LAS unsigned* part = (LAS unsigned*)(F.lds + 65536);
    LAS unsigned* st = (LAS unsigned*)(F.lds + 67584);
    const int tid = F.tid, lane = F.lane, wid = F.wave, r = lane & 31, hi = lane >> 5;
    const int N = 64 * (j + 1), nkt = N / 32, tmax = 4 * (j / 4) + 3;
    const bf16* Z = (const bf16*)(WS + WS_Z);
    u64* mout = (u64*)(WS + WS_MASK) + (size_t)b * 64 * SEQL + (64 * j + 32 * hf);
    if (N <= 256) {
        for (int idx = tid; idx < (tmax + 1) * 32; idx += 512) { const int tile = idx >> 5, q = idx & 31; mout[(size_t)tile * SEQL + q] = tile <= j ? ~0ull : 0ull; }
        return;
    }
    for (int i = tid; i < 16384; i += 512) hist[i] = 0u;
    if (tid < 32) { st[tid] = 0u; st[32 + tid] = 256u; st[64 + tid] = 0u; }
    const bf16* qrow = Z + (size_t)(b * SEQL + 64 * j + 32 * hf + r) * ZW;
    bf16x8 qf[4][4]; float wq[4];
#pragma unroll
    for (int h = 0; h < 4; ++h) {
#pragma unroll
        for (int ks = 0; ks < 4; ++ks) qf[h][ks] = *(const bf16x8*)(qrow + ZC_QI + 64 * h + 16 * ks + 8 * hi);
        wq[h] = bf2f(qrow[ZC_WI + h]) * 0.0625f;
    }
    const bf16* kbase = Z + (size_t)(b * SEQL + r) * ZW + ZC_KI + 8 * hi;
    __syncthreads();
    for (int pass = 0; pass < 5; ++pass) {
        const int shift = 24 - 8 * pass;
        const unsigned prefix = st[r];
        const unsigned himask = pass == 0 ? 0u : (pass >= 4 ? 0xffffffffu : (0xffffffffu << (shift + 8)));
        bf16x8 kfn[4];
        if (wid < nkt) {
#pragma unroll
            for (int ks = 0; ks < 4; ++ks) kfn[ks] = *(const bf16x8*)(kbase + (size_t)(32 * wid) * ZW + 16 * ks); }
        for (int kt = wid; kt < nkt; kt += 8) {
            bf16x8 kf[4];
#pragma unroll
            for (int ks = 0; ks < 4; ++ks) kf[ks] = kfn[ks];
            if (kt + 8 < nkt) {
#pragma unroll
                for (int ks = 0; ks < 4; ++ks) kfn[ks] = *(const bf16x8*)(kbase + (size_t)(32 * (kt + 8)) * ZW + 16 * ks); }
            float sc[16];
#pragma unroll
            for (int g = 0; g < 16; ++g) sc[g] = 0.f;
#pragma unroll
            for (int h = 0; h < 4; ++h) {
                f32x16 acc = {};
#pragma unroll
                for (int ks = 0; ks < 4; ++ks) acc = __builtin_amdgcn_mfma_f32_32x32x16_bf16(kf[ks], qf[h][ks], acc, 0, 0, 0);
#pragma unroll
                for (int g = 0; g < 16; ++g) { const int ib = (int)__float_as_uint(acc[g]); const float rl = __uint_as_float((unsigned)(ib > 0 ? ib : 0)); sc[g] = __builtin_fmaf(wq[h], rl, sc[g]); }
            }
            unsigned key[16];
#pragma unroll
            for (int g = 0; g < 16; ++g) { const unsigned u = __float_as_uint(sc[g]); key[g] = u ^ ((unsigned)((int)u >> 31) | 0x80000000u); }
            if (pass == 0) {
#pragma unroll
                for (int g = 0; g < 16; ++g) __hip_atomic_fetch_add(hist + (key[g] >> 24) * 32 + r, 1u, __ATOMIC_RELAXED, __HIP_MEMORY_SCOPE_WORKGROUP);
            } else if (pass < 4) {
#pragma unroll
                for (int g = 0; g < 16; ++g) {
                    if (((key[g] ^ prefix) & himask) == 0u) __hip_atomic_fetch_add(hist + __builtin_amdgcn_ubfe(key[g], (unsigned)shift, 8u) * 32 + r, 1u, __ATOMIC_RELAXED, __HIP_MEMORY_SCOPE_WORKGROUP); }
            } else {
                unsigned bg = 0u, be = 0u;
#pragma unroll
                for (int g = 0; g < 16; ++g) { const unsigned pos = (unsigned)((g & 3) + 8 * (g >> 2));
                    bg |= (key[g] > prefix ? 1u : 0u) << pos; be |= (key[g] == prefix ? 1u : 0u) << pos; }
                bg <<= 4 * hi; be <<= 4 * hi;
                __hip_atomic_fetch_or(mgt + kt * 32 + r, bg, __ATOMIC_RELAXED, __HIP_MEMORY_SCOPE_WORKGROUP);
                __hip_atomic_fetch_or(meq + kt * 32 + r, be, __ATOMIC_RELAXED, __HIP_MEMORY_SCOPE_WORKGROUP);
            }
        }
        __syncthreads();
        if (pass < 4) {
            const int q = tid & 31, g = tid >> 5;
            unsigned c[16], sum = 0u;
#pragma unroll
            for (int i = 0; i < 16; ++i) { c[i] = hist[(16 * g + i) * 32 + q]; sum += c[i]; hist[(16 * g + i) * 32 + q] = 0u; }
            part[g * 32 + q] = sum;
            const unsigned kr = st[32 + q];
            __syncthreads();
            unsigned above = 0u;
            for (int gg = g + 1; gg < 16; ++gg) above += part[gg * 32 + q];
            if (above < kr && kr <= above + sum) {
                unsigned cum = above; int dig = 16 * g; unsigned ce = 0u;
#pragma unroll
                for (int i = 15; i >= 0; --i) { if (cum < kr && kr <= cum + c[i]) { dig = 16 * g + i; ce = c[i]; st[32 + q] = kr - cum; } cum += c[i]; }
                st[q] |= (unsigned)dig << shift; st[64 + q] = ce;
            }
            __syncthreads();
        }
    }
    {
        const int q = tid & 31, g = tid >> 5;
        const unsigned need = st[32 + q], ce = st[64 + q];
        if (ce > need) {
            if (g == 0) { unsigned taken = 0u;
                for (int kt = 0; kt < nkt; ++kt) { unsigned w = meq[kt * 32 + q]; const unsigned cnt = __popc(w);
                    if (taken + cnt > need) { unsigned keep = 0u; unsigned left = need - taken; while (left) { const unsigned lb = w & (0u - w); keep |= lb; w ^= lb; --left; } w = keep; taken = need; } else taken += cnt;
                    mgt[kt * 32 + q] |= w; } }
        } else {
            for (int kt = g; kt < nkt; kt += 16) mgt[kt * 32 + q] |= meq[kt * 32 + q];
        }
        __syncthreads();
        for (int tile = g; tile <= tmax; tile += 16) {
            const unsigned lo = 2 * tile < nkt ? mgt[(2 * tile) * 32 + q] : 0u, hw = 2 * tile + 1 < nkt ? mgt[(2 * tile + 1) * 32 + q] : 0u;
            mout[(size_t)tile * SEQL + q] = (u64)lo | ((u64)hw << 32);
        }
        __syncthreads();
    }
}
__device__ __forceinline__ void ph_select(Frame& F) {
    { int t_ = threadIdx.x; asm volatile("" : "+v"(t_)); F.tid = t_; F.lane = t_ & 63; F.wave = __builtin_amdgcn_readfirstlane(t_ >> 6); }
    kargs_t ap = kargs(); inarr_t IN = (inarr_t)ap->in; unsigned char* WS = ap->ws; unsigned* CTL = (unsigned*)(WS + WS_CTL); float* OUT = ap->out; (void)IN; (void)OUT; (void)CTL;
    for (int rep_ = 0; rep_ < 1 + ((PH_DOUBLE >> 11) & 1); ++rep_) {
        const bf16* Z = (const bf16*)(WS + WS_Z);
        bf16* Qn = (bf16*)(WS + WS_QN); bf16* Kn = (bf16*)(WS + WS_KN); bf16* YA = (bf16*)(WS + WS_YAB);
        const int lane = F.lane, d0 = (8 * lane) & 63, c0 = 8 * lane;
        float gq[8], gk[8], w0[8], w1[8], w2[8];
#pragma unroll
        for (int i = 0; i < 8; ++i) { gq[i] = IN[I_QNG][d0 + i] * C2; gk[i] = IN[I_KNG][d0 + i]; w0[i] = IN[I_CONVW][c0 + i]; w1[i] = IN[I_CONVW][512 + c0 + i]; w2[i] = IN[I_CONVW][1024 + c0 + i]; }
        for (int tb = F.vcu; tb < MTOK / 64; tb += F.G) {
            const int tok0 = tb * 64 + 8 * F.wave;
            float um2[8], um1[8];
#pragma unroll
            for (int k = 0; k < 2; ++k) { const int tk = tok0 - 2 + k; float* dst = k == 0 ? um2 : um1;
                if ((tok0 & (SEQL - 1)) >= 2 - k) { const bf16* zr = Z + (size_t)tk * ZW; const v4u xi = *(const v4u*)(zr + ZC_XIN + c0), gc = *(const v4u*)(zr + ZC_GC + c0);
                    dst[0] = bflo(xi.x) * bflo(gc.x); dst[1] = bfhi(xi.x) * bfhi(gc.x); dst[2] = bflo(xi.y) * bflo(gc.y); dst[3] = bfhi(xi.y) * bfhi(gc.y);
                    dst[4] = bflo(xi.z) * bflo(gc.z); dst[5] = bfhi(xi.z) * bfhi(gc.z); dst[6] = bflo(xi.w) * bflo(gc.w); dst[7] = bfhi(xi.w) * bfhi(gc.w); }
                else {
#pragma unroll
                    for (int i = 0; i < 8; ++i) dst[i] = 0.f; } }
            for (int i = 0; i < 8; ++i) {
                const int tok = tok0 + i; const bf16* zr = Z + (size_t)tok * ZW;
                const v4u xi = *(const v4u*)(zr + ZC_XIN + c0), gc = *(const v4u*)(zr + ZC_GC + c0), gb = *(const v4u*)(zr + ZC_GB + c0), qv = *(const v4u*)(zr + ZC_Q + c0), kv = *(const v4u*)(zr + ZC_K + c0);
                float u[8] = {bflo(xi.x) * bflo(gc.x), bfhi(xi.x) * bfhi(gc.x), bflo(xi.y) * bflo(gc.y), bfhi(xi.y) * bfhi(gc.y), bflo(xi.z) * bflo(gc.z), bfhi(xi.z) * bfhi(gc.z), bflo(xi.w) * bflo(gc.w), bfhi(xi.w) * bfhi(gc.w)};
                const float gbf[8] = {bflo(gb.x), bfhi(gb.x), bflo(gb.y), bfhi(gb.y), bflo(gb.z), bfhi(gb.z), bflo(gb.w), bfhi(gb.w)};
                float y[8];
#pragma unroll
                for (int k = 0; k < 8; ++k) { y[k] = gbf[k] * (w0[k] * um2[k] + w1[k] * um1[k] + w2[k] * u[k]); um2[k] = um1[k]; um1[k] = u[k]; }
                if ((tok & (SEQL - 1)) == 0) {
                }
                *(v4u*)(YA + (size_t)tok * 512 + c0) = (v4u){pkbf(y[0], y[1]), pkbf(y[2], y[3]), pkbf(y[4], y[5]), pkbf(y[6], y[7])};
                float qf_[8] = {bflo(qv.x), bfhi(qv.x), bflo(qv.y), bfhi(qv.y), bflo(qv.z), bfhi(qv.z), bflo(qv.w), bfhi(qv.w)};
                float kf_[8] = {bflo(kv.x), bfhi(kv.x), bflo(kv.y), bfhi(kv.y), bflo(kv.z), bfhi(kv.z), bflo(kv.w), bfhi(kv.w)};
                float sq = 0.f, sk = 0.f;
#pragma unroll
                for (int k = 0; k < 8; ++k) { sq += qf_[k] * qf_[k]; sk += kf_[k] * kf_[k]; }
                sq += __shfl_xor(sq, 1); sk += __shfl_xor(sk, 1); sq += __shfl_xor(sq, 2); sk += __shfl_xor(sk, 2); sq += __shfl_xor(sq, 4); sk += __shfl_xor(sk, 4);
                const float rq = 1.0f / sqrtf(sq * (1.f / 64.f) + EPSN), rk = 1.0f / sqrtf(sk * (1.f / 64.f) + EPSN);
#pragma unroll
                for (int k = 0; k < 8; ++k) { qf_[k] = qf_[k] * rq * gq[k]; kf_[k] = kf_[k] * rk * gk[k]; }
                *(v4u*)(Qn + (size_t)tok * 512 + c0) = (v4u){pkbf(qf_[0], qf_[1]), pkbf(qf_[2], qf_[3]), pkbf(qf_[4], qf_[5]), pkbf(qf_[6], qf_[7])};
                *(v4u*)(Kn + (size_t)tok * 512 + c0) = (v4u){pkbf(kf_[0], kf_[1]), pkbf(kf_[2], kf_[3]), pkbf(kf_[4], kf_[5]), pkbf(kf_[6], kf_[7])};
            }
        }
    }
    for (int rep_ = 0; rep_ < 1 + ((PH_DOUBLE >> 12) & 1); ++rep_)
    for (int v = F.vcu; v < 256; v += F.G) {
        const int b = v & 3, hf = (v >> 2) & 1, s = v >> 3;
        sel_unit(F, b, 63 - s, hf);
        sel_unit(F, b, s, hf);
    }
}

__device__ __forceinline__ void ph_router(Frame& F, int rep) {
    { int t_ = threadIdx.x; asm volatile("" : "+v"(t_)); F.tid = t_; F.lane = t_ & 63; F.wave = __builtin_amdgcn_readfirstlane(t_ >> 6); }
    kargs_t ap = kargs(); inarr_t IN = (inarr_t)ap->in; unsigned char* WS = ap->ws; unsigned* CTL = (unsigned*)(WS + WS_CTL); float* OUT = ap->out; (void)IN; (void)OUT; (void)CTL;
    LAS f32x4* Wl = (LAS f32x4*)(F.lds);
    LAS unsigned* lcnt = (LAS unsigned*)(F.lds + TAB_OFF);
    LAS unsigned* lbase = lcnt + 32;
    LAS unsigned* ler = lcnt + 64;
    LAS float* lgate = (LAS float*)(lcnt + 64 + 256);
    const float* WR = IN[I_WR]; const float* BR = IN[I_BR];
    const float* mod = (const float*)(CTL + CW_MOD);
    bf16* H = (bf16*)(WS + WS_H);
    int* list = (int*)(WS + WS_LIST); unsigned* toker = (unsigned*)(WS + WS_TOKER); float* tokg = (float*)(WS + WS_TOKG);
    unsigned* gcnt = CTL + CW_ECNT_BASE + 32 * rep;
    const int lane = F.lane;
    for (int idx = F.tid; idx < 8192; idx += 512) { const int l = idx & 63, q = (idx >> 6) & 7, c = (idx >> 9) & 3, j = idx >> 11;
        Wl[idx] = *(const f32x4*)(WR + (size_t)(4 * l + c + 256 * j) * 32 + 4 * q); }
    const int ebit = ((lane >> 5) & 1) * 16 + ((lane >> 4) & 1) * 8 + ((lane >> 3) & 1) * 4 + ((lane >> 2) & 1) * 2 + ((lane >> 1) & 1);
    const float myb = BR[ebit];
    for (int tb = F.vcu; tb < MTOK / 64; tb += F.G) {
        if (F.tid < 32) lcnt[F.tid] = 0u;
        __syncthreads();
        for (int i = 0; i < 8; ++i) {
            const int tl = 8 * F.wave + i, tok = tb * 64 + tl;
            const float* mb = mod + (size_t)(tok >> 12) * 6144;
            const f32x4* xr = (const f32x4*)(OUT + (size_t)tok * 1024) + lane;
            f32x4 v[4]; float s = 0.f;
#pragma unroll
            for (int j = 0; j < 4; ++j) { v[j] = xr[64 * j]; s += (v[j].x * v[j].x + v[j].y * v[j].y) + (v[j].z * v[j].z + v[j].w * v[j].w); }
            const float rstd = 1.0f / sqrtf(wave_sum(s) * (1.f / 1024.f) + EPSN);
            u64* o8 = (u64*)(H + (size_t)tok * 1024) + lane;
            float acc[32];
#pragma unroll
            for (int e = 0; e < 32; ++e) acc[e] = 0.f;
#pragma unroll
            for (int j = 0; j < 4; ++j) {
                const f32x4 gv = ((const f32x4*)IN[I_N2G])[lane + 64 * j], scv = ((const f32x4*)(mb + 4096))[lane + 64 * j], shv = ((const f32x4*)(mb + 3072))[lane + 64 * j];
                const f32x4 y = (v[j] * rstd) * gv * (scv + 1.0f) + shv;
                if (MOE_FP8) ((unsigned*)(WS + WS_H8 + (size_t)tok * 1024))[lane + 64 * j] = pg8::pk4_fp8(y.x, y.y, y.z, y.w);
                else o8[64 * j] = (u64)pkbf(y.x, y.y) | ((u64)pkbf(y.z, y.w) << 32);
#pragma unroll
                for (int c = 0; c < 4; ++c) { const float hv = y[c];
#pragma unroll
                    for (int q = 0; q < 8; ++q) { const f32x4 w = Wl[((j * 4 + c) * 8 + q) * 64 + lane]; acc[4 * q] += hv * w.x; acc[4 * q + 1] += hv * w.y; acc[4 * q + 2] += hv * w.z; acc[4 * q + 3] += hv * w.w; } }
            }
#pragma unroll
            for (int i2 = 0; i2 < 16; ++i2) { const bool up = lane & 32; const float send = up ? acc[i2] : acc[i2 + 16], keep = up ? acc[i2 + 16] : acc[i2]; acc[i2] = keep + __shfl_xor(send, 32); }
#pragma unroll
            for (int i2 = 0; i2 < 8; ++i2) { const bool up = lane & 16; const float send = up ? acc[i2] : acc[i2 + 8], keep = up ? acc[i2 + 8] : acc[i2]; acc[i2] = keep + __shfl_xor(send, 16); }
#pragma unroll
            for (int i2 = 0; i2 < 4; ++i2) { const bool up = lane & 8; const float send = up ? acc[i2] : acc[i2 + 4], keep = up ? acc[i2 + 4] : acc[i2]; acc[i2] = keep + __shfl_xor(send, 8); }
#pragma unroll
            for (int i2 = 0; i2 < 2; ++i2) { const bool up = lane & 4; const float send = up ? acc[i2] : acc[i2 + 2], keep = up ? acc[i2 + 2] : acc[i2]; acc[i2] = keep + __shfl_xor(send, 4); }
            { const bool up = lane & 2; const float send = up ? acc[0] : acc[1], keep = up ? acc[1] : acc[0]; acc[0] = keep + __shfl_xor(send, 2); }
            float logit = acc[0] + __shfl_xor(acc[0], 1) + myb;
            float tv[4]; int te[4];
            unsigned lu = __float_as_uint(logit); unsigned lkey = lu ^ ((unsigned)((int)lu >> 31) | 0x80000000u);
#pragma unroll
            for (int k = 0; k < 4; ++k) {
                u64 best = ((u64)lkey << 32) | (unsigned)(31 - ebit);
#pragma unroll
                for (int o = 1; o < 64; o <<= 1) { const unsigned bh = __shfl_xor((unsigned)(best >> 32), o), bl = __shfl_xor((unsigned)best, o); const u64 ot = ((u64)bh << 32) | bl; best = ot > best ? ot : best; }
                const int we = 31 - (int)(unsigned)best; te[k] = we;
                const unsigned wk = (unsigned)(best >> 32); const unsigned wu = (wk & 0x80000000u) ? (wk ^ 0x80000000u) : ~wk; tv[k] = __uint_as_float(wu);
                if (ebit == we) lkey = 0u;
            }
            const float e1 = expf(tv[1] - tv[0]), e2 = expf(tv[2] - tv[0]), e3 = expf(tv[3] - tv[0]); const float inv = 1.0f / (1.0f + e1 + e2 + e3);
            if (lane < 4) { const int e = lane == 0 ? te[0] : lane == 1 ? te[1] : lane == 2 ? te[2] : te[3]; const float g = (lane == 0 ? 1.0f : lane == 1 ? e1 : lane == 2 ? e2 : e3) * inv;
                const unsigned lr = __hip_atomic_fetch_add(lcnt + e, 1u, __ATOMIC_RELAXED, __HIP_MEMORY_SCOPE_WORKGROUP);
                ler[tl * 4 + lane] = (unsigned)e | (lr << 8); lgate[tl * 4 + lane] = g; }
        }
        __syncthreads();
        if (F.tid < 32) lbase[F.tid] = __hip_atomic_fetch_add(gcnt + F.tid, lcnt[F.tid], RLX_AGENT);
        __syncthreads();
        if (F.tid < 256) { const unsigned er = ler[F.tid]; const int e = er & 255u; const unsigned rank = lbase[e] + (er >> 8); const int tok = tb * 64 + (F.tid >> 2);
            list[(size_t)e * MTOK + rank] = tok; toker[(size_t)tok * 4 + (F.tid & 3)] = (unsigned)e | (rank << 8); tokg[(size_t)tok * 4 + (F.tid & 3)] = lgate[F.tid]; }
        __syncthreads();
    }
}

__device__ __forceinline__ void moe_table(Frame& F) {
    { int t_ = threadIdx.x; asm volatile("" : "+v"(t_)); F.tid = t_; F.lane = t_ & 63; F.wave = __builtin_amdgcn_readfirstlane(t_ >> 6); }
    kargs_t ap = kargs(); inarr_t IN = (inarr_t)ap->in; unsigned char* WS = ap->ws; unsigned* CTL = (unsigned*)(WS + WS_CTL); float* OUT = ap->out; (void)IN; (void)OUT; (void)CTL;
    LAS int* tab = (LAS int*)(F.lds + TAB_OFF);
    if (F.tid == 0) { int nt = 0;
        for (int e = 0; e < NEXP; ++e) { const int c = (int)__hip_atomic_load(CTL + CW_ECNT + e, RLX_AGENT); tab[512 + e] = c; const int n = (c + 255) >> 8; for (int r = 0; r < n; ++r) tab[1 + nt++] = e | (r << 8); }
        tab[0] = nt; }
    __syncthreads();
}
struct MoeOrder {
    const LAS int* tab; int ncol, G, c; const int* list;
    __device__ __forceinline__ bool next(int i, pg8::Unit& u) const {
        const int nM = tab[0], nN = ncol, nwg = nM * nN; const long L = (long)i * G + c; if (L >= nwg) return false;
        int wgid = (int)L; { const int q = nwg / 8, r = nwg % 8, xcd = wgid % 8, off = wgid / 8; wgid = (xcd < r ? xcd * (q + 1) : r * (q + 1) + (xcd - r) * q) + off; }
        const int nig = 8 * nN, gid = wgid / nig, fm = gid * 8, gsz = (nM - fm) < 8 ? (nM - fm) : 8;
        const int pm = fm + ((wgid % nig) % gsz), cn = (wgid % nig) / gsz; const int er = tab[1 + pm];
        u.pm = pm; u.e = er & 255; u.r = er >> 8; u.pn = u.e * ncol + cn; return true;
    }
    __device__ __forceinline__ const int* rows(const pg8::Unit& u, int& cnt) const { cnt = tab[512 + u.e]; return list + (size_t)u.e * MTOK; }
};
struct MergeOrder {
    pg8::StaticOrder so;
    __device__ __forceinline__ bool next(int i, pg8::Unit& u) const { if (!so.next(i >> 1, u)) return false; if (i & 1) { u.pm += 64; u.pn += 4; } return true; }
    __device__ __forceinline__ const int* rows(const pg8::Unit&, int& cnt) const { cnt = 0; return nullptr; }
};

#ifndef DBG_NPH
#define DBG_NPH 11
#endif
__device__ __forceinline__ void ph_combine(Frame& F, bool dummy) {
    { int t_ = threadIdx.x; asm volatile("" : "+v"(t_)); F.tid = t_; F.lane = t_ & 63; F.wave = __builtin_amdgcn_readfirstlane(t_ >> 6); }
    kargs_t ap = kargs(); inarr_t IN = (inarr_t)ap->in; unsigned char* WS = ap->ws; unsigned* CTL = (unsigned*)(WS + WS_CTL); float* OUT = ap->out; (void)IN; (void)OUT; (void)CTL;
    LAS int* tab = (LAS int*)(F.lds + TAB_OFF);
    if (F.tid == 0) { int acc = 0; for (int e = 0; e < NEXP; ++e) { tab[e] = acc; const int c = (int)__hip_atomic_load(CTL + CW_ECNT + e, RLX_AGENT); acc += ((c + 255) >> 8) << 8; } }
    __syncthreads();
    const float* mod = (const float*)(CTL + CW_MOD);
    const bf16* Y = (const bf16*)(WS + (DBG_NPH == 9 ? WS_ACT : WS_YBUF)); const unsigned* toker = (const unsigned*)(WS + WS_TOKER); const float* tokg = (const float*)(WS + WS_TOKG);
    const int gw = F.vcu * NWAVES + F.wave, NGW = F.G * NWAVES, lane = F.lane;
    for (int tok = gw; tok < MTOK; tok += NGW) {
        const float* g2 = mod + (size_t)(tok >> 12) * 6144 + 5120;
        f32x4 a[4];
#pragma unroll
        for (int j = 0; j < 4; ++j) a[j] = (f32x4){0.f, 0.f, 0.f, 0.f};
#pragma unroll
        for (int k = 0; k < 4; ++k) { const unsigned er = toker[(size_t)tok * 4 + k]; const float g = tokg[(size_t)tok * 4 + k]; const int slot = tab[er & 255u] + (int)(er >> 8);
            const u64* yr = (const u64*)(Y + (size_t)slot * 1024) + lane;
            float gg = g; if (DBG_NPH == 8) { yr = (const u64*)((const bf16*)(WS + WS_H) + (size_t)tok * 1024) + lane; gg = g * (float)((er & 255u) + 1u) * 0.0625f; }
#pragma unroll
            for (int j = 0; j < 4; ++j) { const u64 w = yr[64 * j]; const unsigned lo = (unsigned)w, hi = (unsigned)(w >> 32); a[j].x += gg * bflo(lo); a[j].y += gg * bfhi(lo); a[j].z += gg * bflo(hi); a[j].w += gg * bfhi(hi); } }
        f32x4* orow = (f32x4*)(OUT + (size_t)tok * 1024) + lane; f32x4* wrow = dummy ? (f32x4*)((float*)(WS + WS_ACT) + (size_t)tok * 1024) + lane : orow;
#pragma unroll
        for (int j = 0; j < 4; ++j) { const f32x4 gv = ((const f32x4*)g2)[lane + 64 * j]; wrow[64 * j] = orow[64 * j] + gv * a[j]; }
    }
}


constexpr int CW_HASH = 12288;
#ifndef DBG_HMASK
#define DBG_HMASK 0x3ff
#endif
__device__ __forceinline__ void dbg_hash(Frame& F) {
    { int t_ = threadIdx.x; asm volatile("" : "+v"(t_)); F.tid = t_; F.lane = t_ & 63; F.wave = __builtin_amdgcn_readfirstlane(t_ >> 6); }
    kargs_t ap = kargs(); unsigned char* WS = ap->ws; unsigned* CTL = (unsigned*)(WS + WS_CTL);
    const size_t offs[10] = {WS_CTL + (size_t)CW_MOD * 4, WS_WIN, WS_H, WS_Z, WS_QN, WS_YAB, WS_MASK, WS_YAB + (size_t)MTOK * 1024, WS_MRG, 0};
    const size_t lens[10] = {24576 * 4, 208 * MiB, 32 * MiB, 176 * MiB, 32 * MiB, 16 * MiB, 8 * MiB, 16 * MiB, 32 * MiB, 64 * MiB};
    for (int k = 0; k < 10; ++k) {
        const unsigned* p = k == 9 ? (const unsigned*)ap->out : (const unsigned*)(WS + offs[k]); const size_t n = lens[k] / 4;
        unsigned h = 0u;
        for (size_t i = (size_t)F.bx * 512 + F.tid; i < n; i += (size_t)F.G * 512) h += p[i] * (unsigned)(2 * i + 1);
        atomicAdd(CTL + CW_HASH + k, h);
    }
}
__device__ __forceinline__ void dbg_emit(Frame& F) {
    kargs_t ap = kargs(); unsigned char* WS = ap->ws; unsigned* CTL = (unsigned*)(WS + WS_CTL); float* OUT = ap->out;
    for (size_t i = (size_t)F.bx * 512 + threadIdx.x; i < (size_t)MTOK * 1024; i += (size_t)F.G * 512) {
        float v = 0.f;
        if (i < 10) { float sc = (DBG_HMASK >> i) & 1 ? 1.f : 0.f; v = sc * (1.0f + (float)(CTL[CW_HASH + i] & 0x7fffffu) * (1.0f / 8388608.0f)); }
        OUT[i] = v;
    }
}
__global__ void __launch_bounds__(NWAVES * 64, 2) mk_fwd(Args args) {
    extern __shared__ __attribute__((aligned(16))) unsigned char lds[];
    Frame F;
    F.lds = (LAS unsigned char*)lds;
    F.MISC = (volatile LAS unsigned*)(F.lds + MISC_OFF);
    F.tid = threadIdx.x; F.lane = F.tid & 63; F.wave = __builtin_amdgcn_readfirstlane(F.tid >> 6);
    F.G = gridDim.x; F.bx = blockIdx.x; { const int bx = blockIdx.x; F.vcu = (F.G % 8 == 0) ? (bx % 8) * (F.G / 8) + bx / 8 : bx; }
    for (int u = F.tid; u < (LDS_BYTES - LDSCTL_OFF) / 4; u += NWAVES * 64) ((LAS unsigned*)(F.lds + LDSCTL_OFF))[u] = 0u;
    __syncthreads();
    XcdBarrier bar; bar.bar = (unsigned*)(args.ws + WS_CTL) + CW_BAR; bar.x = 0; bar.st = nullptr;
    if (N_LAUNCHES == 1) bar = xcd_barrier_post((unsigned*)(args.ws + WS_CTL) + CW_BAR, F.MISC + 8);
#define GRID_BAR() do { if (N_LAUNCHES == 1) { bar.bar = (unsigned*)(kargs()->ws + WS_CTL) + CW_BAR; xcd_barrier(bar); } } while (0)
    const int lo = args.ph_lo, hi = args.ph_hi;
#ifndef PH_MASK
#define PH_MASK 0x7ff
#endif
#define PH(k) ((((PH_MASK) >> (k)) & 1) && lo <= (k) && (k) < hi)
#ifndef PH_DOUBLE
#define PH_DOUBLE 0
#endif
#define REP(k) for (int rep_ = 0; rep_ < 1 + (((PH_DOUBLE) >> (k)) & 1); ++rep_)
#define BOTH(k) (PH(k) && PH((k) + 1))
#define VIEWS() kargs_t ap = kargs(); inarr_t IN = (inarr_t)ap->in; unsigned char* WS = ap->ws; unsigned* CTL = (unsigned*)(WS + WS_CTL); float* OUT = ap->out; (void)IN; (void)OUT; (void)CTL; \
    bf16* Hb = (bf16*)(WS + WS_H); bf16* Zb = (bf16*)(WS + WS_Z); (void)Hb; (void)Zb
    if (PH(0)) { REP(0) ph_adaln(F); if (BOTH(0)) GRID_BAR(); }
    if (PH(1)) { REP(1) ph_prologue(F); if (BOTH(1)) GRID_BAR(); }
    if (PH(2)) {
        VIEWS();
        pg8::Gemm g{Hb, (const bf16*)(WS + WS_WIN), MTOK, ZW, 1024, 0, 0}; pg8::StaticOrder S; S.init(MTOK, ZW, F.G, F.bx);
        pg8::EpiBf16 E{Zb, ZW, nullptr, 0};
        REP(2) pg8::gemm_phase<pg8::EpiBf16, pg8::StaticOrder, false>(F.lds + RING_OFF, g, S, E);
        if (BOTH(2)) GRID_BAR();
    }
    if (PH(3)) { REP(3) ph_select(F); if (BOTH(3)) GRID_BAR(); }
    if (PH(4)) {
        VIEWS();
        const bf16* Qn = (const bf16*)(WS + WS_QN); const bf16* Kn = (const bf16*)(WS + WS_KN); bf16* YB = (bf16*)(WS + WS_YAB) + (size_t)MTOK * 512;
        REP(4) for (int v = F.vcu; v < 256; v += F.G) { const int bh = v >> 3, s = v & 7;
            attn_body::attn_unit(bh >> 3, bh & 7, 15 - s, Qn, Kn, Zb + ZC_V, ZW, YB, (const u64*)(WS + WS_MASK), (char*)lds + RING_OFF);
            attn_body::attn_unit(bh >> 3, bh & 7, s, Qn, Kn, Zb + ZC_V, ZW, YB, (const u64*)(WS + WS_MASK), (char*)lds + RING_OFF); }
        if (BOTH(4)) GRID_BAR();
    }
    if (PH(5)) {
        VIEWS();
        pg8::Gemm g{(const bf16*)(WS + WS_YAB), (const bf16*)(WS + WS_PAB), 2 * MTOK, 2048, 512, 0, 0}; MergeOrder S; S.so.init(MTOK, 1024, F.G, F.bx);
        pg8::EpiMerge E{(bf16*)(WS + WS_MRG), Zb, ZW, ZC_GA, ZC_GBR};
        REP(5) pg8::gemm_phase<pg8::EpiMerge, MergeOrder, false>(F.lds + RING_OFF, g, S, E);
        if (BOTH(5)) GRID_BAR();
    }
    if (PH(6)) {
        VIEWS();
        pg8::Gemm g{(const bf16*)(WS + WS_MRG), (const bf16*)(WS + WS_WO), MTOK, 1024, 1024, 0, 0}; pg8::StaticOrder S; S.init(MTOK, 1024, F.G, F.bx);
        pg8::EpiResid E{IN[I_X], OUT, (const float*)(CTL + CW_MOD) + 2048};
        REP(6) pg8::gemm_phase<pg8::EpiResid, pg8::StaticOrder, false>(F.lds + RING_OFF, g, S, E);
        if (BOTH(6)) GRID_BAR();
    }
    if (PH(7)) { REP(7) ph_router(F, rep_); if (BOTH(7)) GRID_BAR(); }
    if (PH(8)) {
        moe_table(F);
        VIEWS();
        MoeOrder S{(const LAS int*)(F.lds + TAB_OFF), 8, F.G, F.bx, (const int*)(WS + WS_LIST)};
        if (MOE_FP8) { pg8::Gemm g{(const bf16*)(WS + WS_H8), (const bf16*)(WS + WS_WGU), MTOK, 2048 * NEXP, 1024, ONE_E8M0, W8_SCALE_E8M0};
            pg8::EpiSwiGLU8 E{(unsigned char*)(WS + WS_ACT), IN[I_BGU]};
            REP(8) pg8::gemm_phase<pg8::EpiSwiGLU8, MoeOrder, true, true>(F.lds + RING_OFF, g, S, E); }
        else { pg8::Gemm g{Hb, (const bf16*)(WS + WS_WGU), MTOK, 2048 * NEXP, 1024, 0, 0};
            pg8::EpiSwiGLU E{(bf16*)(WS + WS_ACT), IN[I_BGU]};
            REP(8) pg8::gemm_phase<pg8::EpiSwiGLU, MoeOrder, true, false>(F.lds + RING_OFF, g, S, E); }
        if (BOTH(8)) GRID_BAR();
    }
    if (PH(9)) {
        moe_table(F);
        VIEWS();
        MoeOrder S{(const LAS int*)(F.lds + TAB_OFF), 4, F.G, F.bx, (const int*)(WS + WS_LIST)};
        pg8::EpiBf16 E{(bf16*)(WS + WS_YBUF), 1024, IN[I_BD], 1024};
        if (MOE_FP8) { pg8::Gemm g{(const bf16*)(WS + WS_ACT), (const bf16*)(WS + WS_WD), MAXSLOT, 1024 * NEXP, 1024, ONE_E8M0, W8_SCALE_E8M0};
            REP(9) pg8::gemm_phase<pg8::EpiBf16, MoeOrder, false, true>(F.lds + RING_OFF, g, S, E); }
        else { pg8::Gemm g{(const bf16*)(WS + WS_ACT), (const bf16*)(WS + WS_WD), MAXSLOT, 1024 * NEXP, 1024, 0, 0};
            REP(9) pg8::gemm_phase<pg8::EpiBf16, MoeOrder, false, false>(F.lds + RING_OFF, g, S, E); }
        if (BOTH(9)) GRID_BAR();
    }
    if (PH(10)) { REP(10) ph_combine(F, rep_ == 0 && ((PH_DOUBLE >> 10) & 1)); }
#ifdef PH_XBAR
    for (int xb_ = 0; xb_ < PH_XBAR; ++xb_) GRID_BAR();
#endif
    if (lo == 20) dbg_hash(F);
    if (lo == 21) dbg_emit(F);
#undef PH
#undef BOTH
#undef GRID_BAR
#undef VIEWS
}

extern "C" void kernel_launch(void* const* d_in, const int* in_sizes, int n_in, void* d_out, int out_size, void* d_ws, size_t ws_size, hipStream_t stream) {
    static int grid = 0;
    if (grid == 0) {
        if (n_in != 19 || in_sizes[0] != MTOK * 1024 || out_size != MTOK * 1024 || ws_size < WS_END) { fprintf(stderr, "kernel_launch: unexpected shapes / workspace (n_in %d, ws %zu < %zu)\n", n_in, ws_size, (size_t)WS_END); grid = -1; return; }
        int dev = 0, cus = 0, per_cu = 0;
        if (hipGetDevice(&dev) != hipSuccess || hipDeviceGetAttribute(&cus, hipDeviceAttributeMultiprocessorCount, dev) != hipSuccess) { grid = -1; return; }
        if (hipFuncSetAttribute((const void*)mk_fwd, hipFuncAttributeMaxDynamicSharedMemorySize, LDS_BYTES) != hipSuccess) { fprintf(stderr, "kernel_launch: hipFuncSetAttribute failed\n"); grid = -1; return; }
        if (hipOccupancyMaxActiveBlocksPerMultiprocessor(&per_cu, (const void*)mk_fwd, NWAVES * 64, LDS_BYTES) != hipSuccess || per_cu < 1) fprintf(stderr, "kernel_launch: occupancy query reports %d blocks per CU\n", per_cu);
        (void)hipGetLastError();
        grid = cus;
    }
    if (grid < 0) return;
    if (hipMemsetAsync((char*)d_ws + WS_CTL, 0, CTL_ZERO_BYTES, stream) != hipSuccess) return;
    Args a{};
    for (int i = 0; i < 19; ++i) a.in[i] = (const float*)d_in[i];
    a.out = (float*)d_out; a.ws = (unsigned char*)d_ws;
    if (N_LAUNCHES == 1) { a.ph_lo = 0; a.ph_hi = N_PHASES; hipLaunchKernelGGL(mk_fwd, dim3(grid), dim3(NWAVES * 64), LDS_BYTES, stream, a); }
    else { for (int p = 0; p < DBG_NPH; ++p) { a.ph_lo = p; a.ph_hi = p + 1; hipLaunchKernelGGL(mk_fwd, dim3(grid), dim3(NWAVES * 64), LDS_BYTES, stream, a); }
        if (DBG_NPH == 7) { a.ph_lo = 20; a.ph_hi = 21; hipLaunchKernelGGL(mk_fwd, dim3(grid), dim3(NWAVES * 64), LDS_BYTES, stream, a); a.ph_lo = 21; a.ph_hi = 22; hipLaunchKernelGGL(mk_fwd, dim3(grid), dim3(NWAVES * 64), LDS_BYTES, stream, a); }
        if (DBG_NPH == 9 || DBG_NPH == 8) { a.ph_lo = 10; a.ph_hi = 11; hipLaunchKernelGGL(mk_fwd, dim3(grid), dim3(NWAVES * 64), LDS_BYTES, stream, a); } }
}
```

```cpp
#include <hip/hip_runtime.h>
#include <cstdio>
#include <cstdint>

#ifndef MK_N_LAUNCHES
#define MK_N_LAUNCHES 1
#endif

namespace pg8 {
#define PG8_LAS __attribute__((address_space(3)))
typedef unsigned short bf16_t;
typedef short bf16x8 __attribute__((ext_vector_type(8)));
typedef float f32x4 __attribute__((ext_vector_type(4)));
typedef unsigned u32x4 __attribute__((ext_vector_type(4)));
typedef unsigned u32x2 __attribute__((ext_vector_type(2)));
typedef int i32x4 __attribute__((ext_vector_type(4)));
typedef int i32x8 __attribute__((ext_vector_type(8)));
constexpr int BM = 256, BK = 64, HALF = 128, HTB = HALF * BK * 2, STAGE_BYTES = 8 * HTB, NXCD = 8, WGM = 8;

__host__ __device__ __forceinline__ int lds_byte(int r, int c) { const int st = (r >> 4) * 2 + (c >> 5), rr = r & 15, cc = c & 31, ob = rr * 64 + cc * 2; return st * 1024 + (ob ^ (((ob >> 9) & 1) << 5)); }
__host__ __device__ __forceinline__ void stage_rc(int b, int& R, int& C) { const int st = b / 1024, sb = b % 1024, swz = sb ^ (((sb >> 9) & 1) << 5); R = (st >> 1) * 16 + swz / 64; C = (st & 1) * 32 + (swz % 64) / 2; }
__host__ __device__ __forceinline__ int perm32(int rho) { const int n = rho >> 4, i = rho & 15; return 8 * (i >> 2) + 4 * n + (i & 3); }

struct Unit { int pm, pn; int e, r; };
struct Gemm { const bf16_t* A; const bf16_t* Bt; int M, N, K; int scaleA, scaleB; };

struct StaticOrder {
    int nM, nN, nwg, G, c;
    __host__ __device__ void init(int M, int N, int G_, int c_) { nM = M / BM; nN = N / BM; nwg = nM * nN; G = G_; c = c_; }
    __host__ __device__ bool next(int i, Unit& u) const {
        const long L = (long)i * G + c; if (L >= nwg) return false;
        int wgid = (int)L; { const int q = nwg / NXCD, r = nwg % NXCD, xcd = wgid % NXCD, off = wgid / NXCD; wgid = (xcd < r ? xcd * (q + 1) : r * (q + 1) + (xcd - r) * q) + off; }
        const int nig = WGM * nN, gid = wgid / nig, fm = gid * WGM, gsz = (nM - fm) < WGM ? (nM - fm) : WGM;
        u.pm = fm + ((wgid % nig) % gsz); u.pn = (wgid % nig) / gsz; u.e = 0; u.r = 0; return true;
    }
    __device__ __forceinline__ const int* rows(const Unit&, int& cnt) const { cnt = 0; return nullptr; }
};

__device__ __forceinline__ unsigned cvt_pk_bf16(float lo, float hi) { unsigned r; asm volatile("v_cvt_pk_bf16_f32 %0, %1, %2" : "=v"(r) : "v"(lo), "v"(hi)); return r; }
__device__ __forceinline__ float bf_lo(unsigned w) { return __uint_as_float(w << 16); }
__device__ __forceinline__ float bf_hi(unsigned w) { return __uint_as_float(w & 0xffff0000u); }
__device__ __forceinline__ float fast_sigmoid(float x) { return __builtin_amdgcn_rcpf(1.0f + __builtin_amdgcn_exp2f(-1.4426950408889634f * x)); }

struct EpiBf16 {
    static constexpr bool PERM = true;
    bf16_t* O; int ldc; const float* bias; int colmod;
    __device__ __forceinline__ void operator()(const f32x4 (&acc)[2][2][4][2], const Unit& u, int wr, int wc, int fr, int fq) const {
        const int row0 = u.pm * BM + wr * 64 + fr; int colt = u.pn * BM; if (colmod) colt %= colmod;
        const int col0 = colt + wc * 32 + 8 * fq, bcol0 = u.pn * BM + wc * 32 + 8 * fq;
        f32x4 bv[2][2];
#pragma unroll
        for (int bj = 0; bj < 2; ++bj)
#pragma unroll
            for (int n = 0; n < 2; ++n) bv[bj][n] = bias ? *(const f32x4*)(bias + bcol0 + bj * HALF + 4 * n) : (f32x4){0.f, 0.f, 0.f, 0.f};
#pragma unroll
        for (int ai = 0; ai < 2; ++ai)
#pragma unroll
            for (int m = 0; m < 4; ++m) { bf16_t* rowp = O + (size_t)(row0 + ai * HALF + m * 16) * ldc + col0;
#pragma unroll
                for (int bj = 0; bj < 2; ++bj) { const f32x4 v0 = acc[ai][bj][m][0] + bv[bj][0], v1 = acc[ai][bj][m][1] + bv[bj][1];
                    u32x4 w; w.x = cvt_pk_bf16(v0[0], v0[1]); w.y = cvt_pk_bf16(v0[2], v0[3]); w.z = cvt_pk_bf16(v1[0], v1[1]); w.w = cvt_pk_bf16(v1[2], v1[3]);
                    *(u32x4*)(rowp + bj * HALF) = w; } }
    }
};

struct EpiMerge {
    static constexpr bool PERM = true;
    bf16_t* MRG; const bf16_t* Z; int zw, gcolA, gcolB;
    __device__ __forceinline__ void operator()(const f32x4 (&acc)[2][2][4][2], const Unit& u, int wr, int wc, int fr, int fq) const {
        const int br = u.pm >= 64 ? 1 : 0, pm = u.pm - 64 * br, pn = u.pn - 4 * br;
        const int row0 = pm * BM + wr * 64 + fr, col0 = pn * BM + wc * 32 + 8 * fq, gcol = br ? gcolB : gcolA;
#pragma unroll
        for (int ai = 0; ai < 2; ++ai)
#pragma unroll
            for (int m = 0; m < 4; ++m) { const size_t row = (size_t)(row0 + ai * HALF + m * 16);
#pragma unroll
                for (int bj = 0; bj < 2; ++bj) {
                    const u32x4 g = *(const u32x4*)(Z + row * zw + gcol + col0 + bj * HALF);
                    bf16_t* op = MRG + row * 1024 + col0 + bj * HALF;
                    f32x4 v0 = acc[ai][bj][m][0], v1 = acc[ai][bj][m][1];
                    v0[0] *= fast_sigmoid(bf_lo(g.x)); v0[1] *= fast_sigmoid(bf_hi(g.x)); v0[2] *= fast_sigmoid(bf_lo(g.y)); v0[3] *= fast_sigmoid(bf_hi(g.y));
                    v1[0] *= fast_sigmoid(bf_lo(g.z)); v1[1] *= fast_sigmoid(bf_hi(g.z)); v1[2] *= fast_sigmoid(bf_lo(g.w)); v1[3] *= fast_sigmoid(bf_hi(g.w));
                    if (br) { const u32x4 p = *(const u32x4*)op;
                        v0[0] += bf_lo(p.x); v0[1] += bf_hi(p.x); v0[2] += bf_lo(p.y); v0[3] += bf_hi(p.y); v1[0] += bf_lo(p.z); v1[1] += bf_hi(p.z); v1[2] += bf_lo(p.w); v1[3] += bf_hi(p.w); }
                    u32x4 w; w.x = cvt_pk_bf16(v0[0], v0[1]); w.y = cvt_pk_bf16(v0[2], v0[3]); w.z = cvt_pk_bf16(v1[0], v1[1]); w.w = cvt_pk_bf16(v1[2], v1[3]);
                    *(u32x4*)op = w; } }
    }
};

struct EpiResid {
    static constexpr bool PERM = false;
    const float* X; float* out; const float* gate;
    __device__ __forceinline__ void operator()(const f32x4 (&acc)[2][2][4][2], const Unit& u, int wr, int wc, int fr, int fq) const {
        const int row0 = u.pm * BM + wr * 64 + fr, col0 = u.pn * BM + wc * 32 + 4 * fq;
        const float* gb = gate + (size_t)((u.pm * BM) >> 12) * 6144;
        f32x4 gv[2][2];
#pragma unroll
        for (int bj = 0; bj < 2; ++bj)
#pragma unroll
            for (int n = 0; n < 2; ++n) gv[bj][n] = *(const f32x4*)(gb + col0 + bj * HALF + n * 16);
#pragma unroll
        for (int ai = 0; ai < 2; ++ai)
#pragma unroll
            for (int m = 0; m < 4; ++m) { const size_t off = (size_t)(row0 + ai * HALF + m * 16) * 1024 + col0;
#pragma unroll
                for (int bj = 0; bj < 2; ++bj)
#pragma unroll
                    for (int n = 0; n < 2; ++n) { const f32x4 xv = *(const f32x4*)(X + off + bj * HALF + n * 16);
                        *(f32x4*)(out + off + bj * HALF + n * 16) = xv + gv[bj][n] * acc[ai][bj][m][n]; } }
    }
};

struct EpiSwiGLU {
    static constexpr bool PERM = true;
    bf16_t* ACT; const float* bgu;
    __device__ __forceinline__ void operator()(const f32x4 (&acc)[2][2][4][2], const Unit& u, int wr, int wc, int fr, int fq) const {
        const int e = u.pn >> 3, cn = u.pn & 7;
        const int row0 = u.pm * BM + wr * 64 + fr, col0 = cn * 128 + wc * 32 + 8 * fq;
        const float* bg = bgu + (size_t)e * 2048 + col0;
        f32x4 bG[2], bL[2];
#pragma unroll
        for (int n = 0; n < 2; ++n) { bG[n] = *(const f32x4*)(bg + 4 * n); bL[n] = *(const f32x4*)(bg + 1024 + 4 * n); }
#pragma unroll
        for (int ai = 0; ai < 2; ++ai)
#pragma unroll
            for (int m = 0; m < 4; ++m) { float o[8];
#pragma unroll
                for (int n = 0; n < 2; ++n)
#pragma unroll
                    for (int j = 0; j < 4; ++j) { const float g = fminf(acc[ai][0][m][n][j] + bG[n][j], 7.0f); float l = acc[ai][1][m][n][j] + bL[n][j]; l = fminf(fmaxf(l, -7.0f), 7.0f);
                        o[4 * n + j] = g * fast_sigmoid(1.702f * g) * (l + 1.0f); }
                u32x4 w; w.x = cvt_pk_bf16(o[0], o[1]); w.y = cvt_pk_bf16(o[2], o[3]); w.z = cvt_pk_bf16(o[4], o[5]); w.w = cvt_pk_bf16(o[6], o[7]);
                *(u32x4*)(ACT + (size_t)(row0 + ai * HALF + m * 16) * 1024 + col0) = w; }
    }
};

__device__ __forceinline__ unsigned pk4_fp8(float a, float b, float c, float d) { int w = 0; w = __builtin_amdgcn_cvt_pk_fp8_f32(a, b, w, false); w = __builtin_amdgcn_cvt_pk_fp8_f32(c, d, w, true); return (unsigned)w; }
struct EpiSwiGLU8 {
    static constexpr bool PERM = true;
    unsigned char* ACT; const float* bgu;
    __device__ __forceinline__ void operator()(const f32x4 (&acc)[2][2][4][2], const Unit& u, int wr, int wc, int fr, int fq) const {
        const int e = u.pn >> 3, cn = u.pn & 7;
        const int row0 = u.pm * BM + wr * 64 + fr, col0 = cn * 128 + wc * 32 + 8 * fq;
        const float* bg = bgu + (size_t)e * 2048 + col0;
        f32x4 bG[2], bL[2];
#pragma unroll
        for (int n = 0; n < 2; ++n) { bG[n] = *(const f32x4*)(bg + 4 * n); bL[n] = *(const f32x4*)(bg + 1024 + 4 * n); }
#pragma unroll
        for (int ai = 0; ai < 2; ++ai)
#pragma unroll
            for (int m = 0; m < 4; ++m) { float o[8];
#pragma unroll
                for (int n = 0; n < 2; ++n)
#pragma unroll
                    for (int j = 0; j < 4; ++j) { const float g = fminf(acc[ai][0][m][n][j] + bG[n][j], 7.0f); float l = acc[ai][1][m][n][j] + bL[n][j]; l = fminf(fmaxf(l, -7.0f), 7.0f);
                        o[4 * n + j] = g * fast_sigmoid(1.702f * g) * (l + 1.0f); }
                u32x2 w; w.x = pk4_fp8(o[0], o[1], o[2], o[3]); w.y = pk4_fp8(o[4], o[5], o[6], o[7]);
                *(u32x2*)(ACT + (size_t)(row0 + ai * HALF + m * 16) * 1024 + col0) = w; }
    }
};

template <class Epi, class Sched, bool GATHER = false, bool FP8 = false>
__device__ __forceinline__ void gemm_phase(PG8_LAS unsigned char* lds, const Gemm g, const Sched& S, const Epi& E) {
    int tid_ = threadIdx.x; asm volatile("" : "+v"(tid_));
    const int tid = tid_, wid = __builtin_amdgcn_readfirstlane(tid >> 6), lane = tid & 63, wr = wid >> 2, wc = wid & 3, fr = lane & 15, fq = lane >> 4;
    const int K = g.K, KB = FP8 ? K : 2 * K, nt = KB / 128;
    unsigned voffB[2]; unsigned offA[2][2], offAn[2][2]; int Rr[2], Cc[2];
#pragma unroll
    for (int i = 0; i < 2; ++i) { int R, C; stage_rc(tid * 16 + i * 8192, R, C); const int Rb = Epi::PERM ? ((R & ~31) + perm32(R & 31)) : R; Rr[i] = R; Cc[i] = C;
        voffB[i] = (unsigned)(Rb * KB + C * 2); }
    const size_t kstep = (size_t)(BK * 2);
    const size_t hstep = (size_t)HALF * KB;
    const size_t tstep = 2 * hstep;
    const unsigned ldsw = (unsigned)wid * 1024u;
    const int aoff = lds_byte(wr * 64 + fr, fq * 8), boff = lds_byte(wc * 32 + fr, fq * 8);
#define PG8_SA(b, h) (((b) * 2 + (h)) * HTB)
#define PG8_SB(b, h) ((4 + (b) * 2 + (h)) * HTB)
#define PG8_STAGE(bufoff, gbase, voff) do { _Pragma("unroll") for (int _i = 0; _i < 2; ++_i) \
        __builtin_amdgcn_global_load_lds((const unsigned*)((const char*)(gbase) + (voff)[_i]), (PG8_LAS unsigned*)(lds + (bufoff) + ldsw + _i * 8192), 16, 0, 0); } while (0)
#define PG8_LD8(off_) __builtin_shufflevector(*(const PG8_LAS i32x4*)(lds + (off_)), *(const PG8_LAS i32x4*)(lds + (off_) + 1024), 0, 1, 2, 3, 4, 5, 6, 7)
#define PG8_LDA(dst, b, h) do { if constexpr (FP8) { _Pragma("unroll") for (int m = 0; m < 4; ++m) dst##8[m] = PG8_LD8(PG8_SA(b, h) + aoff + m * 2048); } \
        else { _Pragma("unroll") for (int m = 0; m < 4; ++m) _Pragma("unroll") for (int k = 0; k < 2; ++k) dst[m][k] = *(const PG8_LAS bf16x8*)(lds + PG8_SA(b, h) + aoff + m * 2048 + k * 1024); } } while (0)
#define PG8_LDB(dst, b, h) do { if constexpr (FP8) { _Pragma("unroll") for (int n = 0; n < 2; ++n) dst##8[n] = PG8_LD8(PG8_SB(b, h) + boff + n * 2048); } \
        else { _Pragma("unroll") for (int n = 0; n < 2; ++n) _Pragma("unroll") for (int k = 0; k < 2; ++k) dst[n][k] = *(const PG8_LAS bf16x8*)(lds + PG8_SB(b, h) + boff + n * 2048 + k * 1024); } } while (0)
#define PG8_CAT8(x) __builtin_shufflevector(__builtin_bit_cast(i32x4, (x)[0]), __builtin_bit_cast(i32x4, (x)[1]), 0, 1, 2, 3, 4, 5, 6, 7)
#define PG8_MMA(ai, bj, At, Bt) do { __builtin_amdgcn_s_setprio(1); \
        if constexpr (FP8) { _Pragma("unroll") for (int m = 0; m < 4; ++m) _Pragma("unroll") for (int n = 0; n < 2; ++n) \
            asm volatile("v_mfma_scale_f32_16x16x128_f8f6f4 %0, %1, %2, %0, %3, %4 op_sel_hi:[0,0,0]" : "+v"(acc[ai][bj][m][n]) : "v"(Bt##8[n]), "v"(At##8[m]), "v"(scB_), "v"(scA_)); } \
        else { _Pragma("unroll") for (int m = 0; m < 4; ++m) _Pragma("unroll") for (int n = 0; n < 2; ++n) _Pragma("unroll") for (int k = 0; k < 2; ++k) \
            acc[ai][bj][m][n] = __builtin_amdgcn_mfma_f32_16x16x32_bf16(Bt[n][k], At[m][k], acc[ai][bj][m][n], 0, 0, 0); } __builtin_amdgcn_s_setprio(0); } while (0)
#define PG8_WAIT_V(n) asm volatile("s_waitcnt vmcnt(" #n ")" ::: "memory")
#define PG8_WAIT_L(n) asm volatile("s_waitcnt lgkmcnt(" #n ")" ::: "memory")
#define PG8_BAR __builtin_amdgcn_s_barrier()
#define PG8_SCHED __builtin_amdgcn_sched_barrier(0)
#define PG8_AOFFS(dst, U) do { if constexpr (GATHER) { int cnt_; const int* rl_ = S.rows(U, cnt_); \
        _Pragma("unroll") for (int h_ = 0; h_ < 2; ++h_) _Pragma("unroll") for (int i_ = 0; i_ < 2; ++i_) { const int rr_ = (U).r * 256 + h_ * HALF + Rr[i_]; const int tk_ = rr_ < cnt_ ? rl_[rr_] : 0; \
            dst[h_][i_] = (unsigned)tk_ * (unsigned)KB + (unsigned)(Cc[i_] * 2); } } \
      else { _Pragma("unroll") for (int h_ = 0; h_ < 2; ++h_) _Pragma("unroll") for (int i_ = 0; i_ < 2; ++i_) dst[h_][i_] = (unsigned)((h_ * HALF + Rr[i_]) * KB + Cc[i_] * 2); } } while (0)
    Unit cur, nxt; int ui = 0;
    if (!S.next(0, cur)) return;
    f32x4 acc[2][2][4][2];
#pragma unroll
    for (int a = 0; a < 2; ++a)
#pragma unroll
        for (int b = 0; b < 2; ++b)
#pragma unroll
            for (int m = 0; m < 4; ++m)
#pragma unroll
                for (int n = 0; n < 2; ++n) { acc[a][b][m][n] = (f32x4){0.f, 0.f, 0.f, 0.f}; asm volatile("" : "+v"(acc[a][b][m][n])); }
    int scA_ = g.scaleA, scB_ = g.scaleB; asm volatile("" : "+v"(scA_), "+v"(scB_));
    bf16x8 At[4][2], B0[2][2], B1[2][2]; i32x8 At8[4], B08[2], B18[2];
    const char* cA = GATHER ? (const char*)g.A : (const char*)g.A + (size_t)cur.pm * tstep; const char* cB = (const char*)g.Bt + (size_t)cur.pn * tstep;
    PG8_AOFFS(offA, cur);
    PG8_STAGE(PG8_SB(0, 0), cB, voffB); PG8_STAGE(PG8_SB(0, 1), cB + hstep, voffB); PG8_STAGE(PG8_SA(0, 0), cA, offA[0]); PG8_STAGE(PG8_SA(0, 1), cA, offA[1]);
    if (wr == 1) PG8_BAR;
    PG8_WAIT_V(2); PG8_BAR;
    PG8_STAGE(PG8_SB(1, 0), cB + kstep, voffB); PG8_STAGE(PG8_SA(1, 0), cA + kstep, offA[0]); PG8_STAGE(PG8_SB(1, 1), cB + hstep + kstep, voffB);
    PG8_WAIT_V(6); PG8_BAR;
    for (;;) {
        const bool has_next = S.next(ui + 1, nxt);
        const char* nA = has_next ? (GATHER ? (const char*)g.A : (const char*)g.A + (size_t)nxt.pm * tstep) : cA; const char* nB = has_next ? (const char*)g.Bt + (size_t)nxt.pn * tstep : cB;
        if constexpr (GATHER) { if (has_next) { PG8_AOFFS(offAn, nxt); } else {
#pragma unroll
            for (int h = 0; h < 2; ++h)
#pragma unroll
                for (int i = 0; i < 2; ++i) offAn[h][i] = offA[h][i]; } }
        else {
#pragma unroll
            for (int h = 0; h < 2; ++h)
#pragma unroll
                for (int i = 0; i < 2; ++i) offAn[h][i] = offA[h][i]; }
        for (int t = 0; t < nt; t += 2) {
            const bool last = (t == nt - 2);
            const char* a1 = cA + (size_t)(t + 1) * kstep;
            const char* a2 = last ? nA : cA + (size_t)(t + 2) * kstep; const char* b2 = last ? nB : cB + (size_t)(t + 2) * kstep;
            const char* a3 = a2 + kstep; const char* b3 = b2 + kstep;
            unsigned o2[2][2];
#pragma unroll
            for (int h = 0; h < 2; ++h)
#pragma unroll
                for (int i = 0; i < 2; ++i) o2[h][i] = (GATHER && last) ? offAn[h][i] : offA[h][i];
            PG8_LDB(B0, 0, 0); PG8_LDB(B1, 0, 1); PG8_SCHED; PG8_LDA(At, 0, 0); PG8_STAGE(PG8_SA(1, 1), a1, offA[1]);
            PG8_WAIT_V(8); PG8_WAIT_L(0); PG8_BAR; PG8_MMA(0, 0, At, B0); PG8_MMA(0, 1, At, B1); PG8_BAR; PG8_SCHED;
            PG8_LDA(At, 0, 1); PG8_STAGE(PG8_SB(0, 0), b2, voffB); PG8_STAGE(PG8_SB(0, 1), b2 + hstep, voffB); PG8_STAGE(PG8_SA(0, 0), a2, o2[0]);
            PG8_WAIT_V(8); PG8_WAIT_L(0); PG8_BAR; PG8_MMA(1, 0, At, B0); PG8_MMA(1, 1, At, B1); PG8_BAR; PG8_SCHED;
            PG8_LDB(B0, 1, 0); PG8_LDB(B1, 1, 1); PG8_SCHED; PG8_LDA(At, 1, 0); PG8_STAGE(PG8_SA(0, 1), a2, o2[1]);
            PG8_WAIT_V(8); PG8_WAIT_L(0); PG8_BAR; PG8_MMA(0, 0, At, B0); PG8_MMA(0, 1, At, B1); PG8_BAR; PG8_SCHED;
            PG8_LDA(At, 1, 1); PG8_STAGE(PG8_SB(1, 0), b3, voffB); PG8_STAGE(PG8_SB(1, 1), b3 + hstep, voffB); PG8_STAGE(PG8_SA(1, 0), a3, o2[0]);
            PG8_WAIT_V(8); PG8_WAIT_L(0); PG8_BAR; PG8_MMA(1, 0, At, B0); PG8_MMA(1, 1, At, B1); PG8_BAR; PG8_SCHED;
        }
        if (wr == 0) PG8_BAR;
        if constexpr (FP8) asm volatile("s_nop 15\n\ts_nop 7" ::: "memory");
        E(acc, cur, wr, wc, fr, fq);
        if (!has_next) break;
#pragma unroll
        for (int a = 0; a < 2; ++a)
#pragma unroll
            for (int b = 0; b < 2; ++b)
#pragma unroll
                for (int m = 0; m < 4; ++m)
#pragma unroll
                    for (int n = 0; n < 2; ++n) { acc[a][b][m][n] = (f32x4){0.f, 0.f, 0.f, 0.f}; asm volatile("" : "+v"(acc[a][b][m][n])); }
        cur = nxt; cA = nA; cB = nB; ++ui;
#pragma unroll
        for (int h = 0; h < 2; ++h)
#pragma unroll
            for (int i = 0; i < 2; ++i) offA[h][i] = offAn[h][i];
        if (wr == 1) PG8_BAR;
    }
    PG8_WAIT_V(0);
    PG8_BAR;
#undef PG8_SA
#undef PG8_SB
#undef PG8_STAGE
#undef PG8_LDA
#undef PG8_LDB
#undef PG8_MMA
#undef PG8_CAT8
#undef PG8_LD8
#undef PG8_WAIT_V
#undef PG8_WAIT_L
#undef PG8_BAR
#undef PG8_SCHED
#undef PG8_AOFFS
}
}
namespace attn_body {
using bf16x8=__attribute__((ext_vector_type(8)))short;
using s16x4=__attribute__((ext_vector_type(4)))short;
using f32x16=__attribute__((ext_vector_type(16)))float;
using u32x4=__attribute__((ext_vector_type(4)))unsigned;
typedef unsigned short bf16;
constexpr int NHEAD=8,SEQ=4096,D=64;
constexpr int PQ=512,PK=512,PO=512;
constexpr int NW=8,QBLK=32,QB=QBLK*NW,KVBLK=64;
__device__ __forceinline__ int crow(int r,int hi){return (r&3)+8*(r>>2)+4*hi;}
#define SBAR() __builtin_amdgcn_sched_barrier(0)
constexpr int NSLOT=3, SLOTB=8192;
constexpr int LDS_K=0, LDS_V=NSLOT*SLOTB, LDS_WS=2*NSLOT*SLOTB, LDS_OST=LDS_WS+NW*64*4, LDS_BYTES=LDS_OST+NW*4096;
__device__ __forceinline__ void glds16(const void*gsrc,unsigned lds_dst){unsigned keep;
  asm volatile("s_mov_b32 %0, m0\n\ts_mov_b32 m0, %2\n\ts_nop 0\n\tglobal_load_lds_dwordx4 %1, off\n\ts_mov_b32 m0, %0":"=&s"(keep):"v"(gsrc),"s"(lds_dst):"memory");}
typedef float f32x2_t __attribute__((ext_vector_type(2))); typedef __bf16 bf16x2_t __attribute__((ext_vector_type(2)));
__device__ __forceinline__ unsigned cvtpk_s(float lo,float hi){f32x2_t v={lo,hi};bf16x2_t b=__builtin_convertvector(v,bf16x2_t);return __builtin_bit_cast(unsigned,b);}
#define WAIT_BAR(N) asm volatile("s_waitcnt vmcnt(" #N ") lgkmcnt(0)\n\ts_barrier":::"memory")
#define WAIT_BAR_M(N,M) asm volatile("s_waitcnt vmcnt(" #N ") lgkmcnt(0)\n\ts_barrier":"+v"(M)::"memory")

__device__ __forceinline__ void qkt(f32x16&p0,f32x16&p1,const char*Kslot,const bf16x8*qr,int r32,int hi){
  const f32x16 negm={};
  const char*kb=Kslot+hi*1024+r32*16;
  #pragma unroll
  for(int d0=0;d0<4;++d0){
    const bf16x8 b0=*reinterpret_cast<const bf16x8*>(kb+d0*2048);
    const bf16x8 b1=*reinterpret_cast<const bf16x8*>(kb+d0*2048+512);
    if(d0==0){p0=__builtin_amdgcn_mfma_f32_32x32x16_bf16(b0,qr[0],negm,0,0,0);p1=__builtin_amdgcn_mfma_f32_32x32x16_bf16(b1,qr[0],negm,0,0,0);}
    else{p0=__builtin_amdgcn_mfma_f32_32x32x16_bf16(b0,qr[d0],p0,0,0,0);p1=__builtin_amdgcn_mfma_f32_32x32x16_bf16(b1,qr[d0],p1,0,0,0);}}
}
typedef __attribute__((address_space(3))) const char* lds_cptr;
typedef short v4i16_t __attribute__((ext_vector_type(4)));
__device__ __forceinline__ void kload8(bf16x8*kf,lds_cptr kp){
  kf[0]=*(const __attribute__((address_space(3))) bf16x8*)(kp);      kf[1]=*(const __attribute__((address_space(3))) bf16x8*)(kp+512);
  kf[2]=*(const __attribute__((address_space(3))) bf16x8*)(kp+2048); kf[3]=*(const __attribute__((address_space(3))) bf16x8*)(kp+2560);
  kf[4]=*(const __attribute__((address_space(3))) bf16x8*)(kp+4096); kf[5]=*(const __attribute__((address_space(3))) bf16x8*)(kp+4608);
  kf[6]=*(const __attribute__((address_space(3))) bf16x8*)(kp+6144); kf[7]=*(const __attribute__((address_space(3))) bf16x8*)(kp+6656);
}
__device__ __forceinline__ void kload2(bf16x8*kf,lds_cptr kp,int j){ kf[2*j]=*(const __attribute__((address_space(3))) bf16x8*)(kp+j*2048); kf[2*j+1]=*(const __attribute__((address_space(3))) bf16x8*)(kp+j*2048+512); }
__device__ __forceinline__ s16x4 vtr(lds_cptr p){ return __builtin_bit_cast(s16x4,__builtin_amdgcn_ds_read_tr16_b64_v4i16((__attribute__((address_space(3))) v4i16_t*)p)); }
__device__ __forceinline__ void pv(f32x16*o,int vb,bf16x8 pa0,bf16x8 pa1,bf16x8 pa2,bf16x8 pa3){
  #pragma unroll
  for(int d0=0;d0<2;++d0){s16x4 lo[4],hi[4];
    #pragma unroll
    for(int ks=0;ks<4;++ks){
      asm volatile("ds_read_b64_tr_b16 %0,%1 offset:%c2":"=&v"(lo[ks]):"v"(vb),"i"(d0*4096+ks*1024):"memory");
      asm volatile("ds_read_b64_tr_b16 %0,%1 offset:%c2":"=&v"(hi[ks]):"v"(vb),"i"(d0*4096+ks*1024+512):"memory");}
    asm volatile("s_waitcnt lgkmcnt(0)":::"memory");SBAR();
    #define PK(k) (bf16x8){lo[k][0],lo[k][1],lo[k][2],lo[k][3],hi[k][0],hi[k][1],hi[k][2],hi[k][3]}
    o[d0]=__builtin_amdgcn_mfma_f32_32x32x16_bf16(pa0,PK(0),o[d0],0,0,0);
    o[d0]=__builtin_amdgcn_mfma_f32_32x32x16_bf16(pa1,PK(1),o[d0],0,0,0);
    o[d0]=__builtin_amdgcn_mfma_f32_32x32x16_bf16(pa2,PK(2),o[d0],0,0,0);
    o[d0]=__builtin_amdgcn_mfma_f32_32x32x16_bf16(pa3,PK(3),o[d0],0,0,0);
    #undef PK
  }
}
#define MBIT(W,r) ((unsigned)__builtin_amdgcn_sbfe((int)(W),(unsigned)(((r)&3)+8*((r)>>2)),1u))
#define MEXP(X,r,W) X[r]=__uint_as_float(__float_as_uint(__builtin_amdgcn_exp2f(X[r]))&MBIT(W,r))
typedef unsigned long long u64;
__device__ __forceinline__ void attn_unit(int b,int h,int qb,const bf16*Q,const bf16*__restrict__ K,const bf16*__restrict__ V,int PV_,bf16*O,const u64*MASK,char*shm){
  int tid_=threadIdx.x; asm volatile("":"+v"(tid_)); const int tid=tid_,lane=tid&63,r32=lane&31,hi=lane>>5; const int wid=__builtin_amdgcn_readfirstlane(tid>>6);
  const long rowbase=(long)b*SEQ; const int q0=qb*QB;
  const bf16*Qw=Q+(rowbase+q0+wid*QBLK)*PQ+h*D;
  const bf16*Kh=K+rowbase*PK+h*D,*Vh=V+rowbase*PV_+h*D;
  const unsigned lds0=(unsigned)(uintptr_t)shm;
  float*wsf=(float*)(shm+LDS_WS)+wid*64;
  const bf16*ksrc=Kh+(long)lane*PK+wid*8;
  const bf16*vsrc=Vh+(long)(16*(wid&3)+(lane>>2))*PV_+(wid>>2)*32+(lane&3)*8;
  const unsigned kdst=lds0+LDS_K+wid*1024, vdst=lds0+LDS_V+wid*1024;
  #define DMA_K(t,slot) glds16(ksrc+(long)(t)*KVBLK*PK,(unsigned)__builtin_amdgcn_readfirstlane(kdst+(slot)))
  #define DMA_V(t,slot) glds16(vsrc+(long)(t)*KVBLK*PV_,(unsigned)__builtin_amdgcn_readfirstlane(vdst+(slot)))
  const u64*mptr=MASK+((long)b*64*SEQ)+(q0+wid*QBLK+r32);
  #define MLOAD(dst,t) dst=mptr[(long)(t)*SEQ]
  const int vb0=(int)(lds0+LDS_V)+((lane>>4)&1)*32+(lane&3)*8+(4*hi+((lane&15)>>2))*64;
  const char*Kbase=shm+LDS_K; bf16x8 kf[8];
  const lds_cptr shm3=(lds_cptr)shm; const lds_cptr kp0=shm3+LDS_K+hi*1024+r32*16; const lds_cptr vp0=shm3+LDS_V+((lane>>4)&1)*32+(lane&3)*8+(4*hi+((lane&15)>>2))*64;
  const int NT=(q0+QB)/KVBLK;
  u64 mA,mB;
  MLOAD(mA,0);
  DMA_K(0,0);DMA_V(0,0);DMA_K(1,SLOTB);
  bf16x8 qr[4];
  #pragma unroll
  for(int d0=0;d0<4;++d0)qr[d0]=*reinterpret_cast<const bf16x8*>(&Qw[(long)r32*PQ+d0*16+hi*8]);
  float l_reg=0.f;f32x16 o[2];o[0]=f32x16{};o[1]=f32x16{};const f32x16 negm={};
  const int msh=4*hi;
  f32x16 pA0,pA1,pB0,pB1;
  int sl_prev=0,sl_cur=0,sl_next=SLOTB;
  #define ROT() do{sl_prev=sl_cur;sl_cur=sl_next;sl_next=(sl_next==(NSLOT-1)*SLOTB)?0:sl_next+SLOTB;}while(0)
  DMA_K(2,2*SLOTB);
  WAIT_BAR(3);
  qkt(pA0,pA1,Kbase,qr,r32,hi);asm volatile("s_nop 15\n\ts_nop 7":"+v"(pA0),"+v"(pA1));
  { const unsigned w0=(unsigned)mA>>msh, w1=(unsigned)(mA>>32)>>msh;
    _Pragma("unroll") for(int r=0;r<16;++r){ MEXP(pA0,r,w0); MEXP(pA1,r,w1); } }
  WAIT_BAR(0);
  MLOAD(mB,1);
  DMA_K(3,0);DMA_V(1,SLOTB);
  ROT();
  kload8(kf,kp0+sl_cur);
  WAIT_BAR(2);
  s16x4 vlo[8],vhi[8]; u32x4 pw0,pw1,pw2,pw3;
  #define PKW(P,B) cvtpk_s(P[B],P[B+1])
  #define PAF(k) __builtin_bit_cast(bf16x8,pw##k)
  #define VFR(i) (bf16x8){vlo[i][0],vlo[i][1],vlo[i][2],vlo[i][3],vhi[i][0],vhi[i][1],vhi[i][2],vhi[i][3]}
  #define PIN(x) asm volatile("":"+v"(x))
  #define GAPA(MF,A0,A1,A2,A3,W0,W1,PW) do{ MF; sacc+=A0; sacc+=A1; sacc+=A2; sacc+=A3; PIN(sacc); W0; W1; PIN(PW); SBAR(); }while(0)
  #define GAPB(MF,X,B,W) do{ MF; MEXP(X,B,W); MEXP(X,B+1,W); MEXP(X,B+2,W); MEXP(X,B+3,W); PIN(X); SBAR(); }while(0)
  #define VRD(i) do{ vlo[i]=vtr(vp_+(((i)>>2)*4096+((i)&3)*1024)); vhi[i]=vtr(vp_+(((i)>>2)*4096+((i)&3)*1024+512)); }while(0)
  #define KRD(G,j) do{ if(G){ kload2(kf,kp0+sl_next,j); SBAR(); } }while(0)
  #define STEP(C0,C1,P0,P1,t,GK,GV,GL,MC,MN,GM) do{ SBAR(); \
    unsigned w0_=(unsigned)(MC)>>msh, w1_=(unsigned)((MC)>>32)>>msh; asm volatile("":"+v"(w0_),"+v"(w1_)); \
    if(GM){MLOAD(MN,(t)+1);} if(GK){DMA_K((t)+3,sl_cur);} if(GV){DMA_V((t)+1,sl_next);} SBAR(); \
    const lds_cptr vp_=vp0+sl_prev; \
    VRD(0); SBAR(); float sacc=(P0[0]+P0[1]); \
    GAPA(C0=__builtin_amdgcn_mfma_f32_32x32x16_bf16(kf[0],qr[0],negm,0,0,0), P0[2],P0[3],P0[4],P0[5],     pw0[0]=PKW(P0,0), pw0[1]=PKW(P0,2), pw0); \
    VRD(4); SBAR(); GAPA(C1=__builtin_amdgcn_mfma_f32_32x32x16_bf16(kf[1],qr[0],negm,0,0,0), P0[6],P0[7],P0[8],P0[9],     pw0[2]=PKW(P0,4), pw0[3]=PKW(P0,6), pw0); \
    VRD(1); SBAR(); GAPA(C0=__builtin_amdgcn_mfma_f32_32x32x16_bf16(kf[2],qr[1],C0,0,0,0),   P0[10],P0[11],P0[12],P0[13], pw1[0]=PKW(P0,8), pw1[1]=PKW(P0,10), pw1); \
    VRD(5); SBAR(); GAPA(C1=__builtin_amdgcn_mfma_f32_32x32x16_bf16(kf[3],qr[1],C1,0,0,0),   P0[14],P0[15],P1[0],P1[1],   pw1[2]=PKW(P0,12),pw1[3]=PKW(P0,14), pw1); \
    VRD(2); SBAR(); GAPA(C0=__builtin_amdgcn_mfma_f32_32x32x16_bf16(kf[4],qr[2],C0,0,0,0),   P1[2],P1[3],P1[4],P1[5],     pw2[0]=PKW(P1,0), pw2[1]=PKW(P1,2), pw2); \
    VRD(6); SBAR(); GAPA(C1=__builtin_amdgcn_mfma_f32_32x32x16_bf16(kf[5],qr[2],C1,0,0,0),   P1[6],P1[7],P1[8],P1[9],     pw2[2]=PKW(P1,4), pw2[3]=PKW(P1,6), pw2); \
    VRD(3); SBAR(); GAPA(C0=__builtin_amdgcn_mfma_f32_32x32x16_bf16(kf[6],qr[3],C0,0,0,0),   P1[10],P1[11],P1[12],P1[13], pw3[0]=PKW(P1,8), pw3[1]=PKW(P1,10), pw3); \
    VRD(7); SBAR(); GAPA(C1=__builtin_amdgcn_mfma_f32_32x32x16_bf16(kf[7],qr[3],C1,0,0,0),   P1[14],P1[15],0.f,0.f,       pw3[2]=PKW(P1,12),pw3[3]=PKW(P1,14), pw3); \
    l_reg+=sacc; \
    SBAR(); \
    GAPB(o[0]=__builtin_amdgcn_mfma_f32_32x32x16_bf16(PAF(0),VFR(0),o[0],0,0,0), C0,0,w0_); \
    GAPB(o[1]=__builtin_amdgcn_mfma_f32_32x32x16_bf16(PAF(0),VFR(4),o[1],0,0,0), C0,4,w0_); \
    KRD(GL,0); GAPB(o[0]=__builtin_amdgcn_mfma_f32_32x32x16_bf16(PAF(1),VFR(1),o[0],0,0,0), C0,8,w0_); \
    KRD(GL,1); GAPB(o[1]=__builtin_amdgcn_mfma_f32_32x32x16_bf16(PAF(1),VFR(5),o[1],0,0,0), C0,12,w0_); \
    KRD(GL,2); GAPB(o[0]=__builtin_amdgcn_mfma_f32_32x32x16_bf16(PAF(2),VFR(2),o[0],0,0,0), C1,0,w1_); \
    KRD(GL,3); GAPB(o[1]=__builtin_amdgcn_mfma_f32_32x32x16_bf16(PAF(2),VFR(6),o[1],0,0,0), C1,4,w1_); \
    GAPB(o[0]=__builtin_amdgcn_mfma_f32_32x32x16_bf16(PAF(3),VFR(3),o[0],0,0,0), C1,8,w1_); \
    GAPB(o[1]=__builtin_amdgcn_mfma_f32_32x32x16_bf16(PAF(3),VFR(7),o[1],0,0,0), C1,12,w1_); \
    }while(0)
  int t=1;
  for(;t+5<NT;t+=2){
    STEP(pB0,pB1,pA0,pA1,t,true,true,true,mB,mA,true);     WAIT_BAR(2); ROT();
    STEP(pA0,pA1,pB0,pB1,t+1,true,true,true,mA,mB,true);   WAIT_BAR(2); ROT();
  }
  #define ENDW(tt,M) do{ if((tt)+3<NT){WAIT_BAR(2);} else if((tt)+2<NT){WAIT_BAR(1);} else {WAIT_BAR(0);} }while(0)
  for(;t+1<NT;t+=2){
    STEP(pB0,pB1,pA0,pA1,t,(t+3<NT),(t+1<NT),(t+1<NT),mB,mA,(t+1<NT));       ENDW(t,mA);   ROT();
    STEP(pA0,pA1,pB0,pB1,t+1,(t+4<NT),(t+2<NT),(t+2<NT),mA,mB,(t+2<NT));     ENDW(t+1,mB); ROT();
  }
  STEP(pB0,pB1,pA0,pA1,NT-1,false,false,false,mB,mA,false);
  { float sacc=pB0[0]+pB0[1]; _Pragma("unroll") for(int r=2;r<16;++r)sacc+=pB0[r]; _Pragma("unroll") for(int r=0;r<16;++r)sacc+=pB1[r]; l_reg+=sacc;
    pw0=(u32x4){PKW(pB0,0),PKW(pB0,2),PKW(pB0,4),PKW(pB0,6)};pw1=(u32x4){PKW(pB0,8),PKW(pB0,10),PKW(pB0,12),PKW(pB0,14)};pw2=(u32x4){PKW(pB1,0),PKW(pB1,2),PKW(pB1,4),PKW(pB1,6)};pw3=(u32x4){PKW(pB1,8),PKW(pB1,10),PKW(pB1,12),PKW(pB1,14)};
    SBAR(); pv(o,vb0+sl_cur,PAF(0),PAF(1),PAF(2),PAF(3)); }
  #undef PKW
  #undef PAF
  #undef VFR
  #undef PIN
  #undef GAPA
  #undef GAPB
  #undef VRD
  #undef KRD
  #undef STEP
  #undef ENDW
  {auto rr=__builtin_amdgcn_permlane32_swap(__float_as_uint(l_reg),__float_as_uint(l_reg),false,false);l_reg=__uint_as_float(rr[0])+__uint_as_float(rr[1]);}
  if(hi==0)wsf[32+r32]=l_reg;asm volatile("s_waitcnt lgkmcnt(0)":::"memory");
  float rli[16];
  #pragma unroll
  for(int r=0;r<16;++r)rli[r]=__builtin_amdgcn_rcpf(wsf[32+crow(r,hi)]);
  bf16*Ow=O+(rowbase+q0+wid*QBLK)*PO+h*D;
  { bf16*stg=(bf16*)(shm+LDS_OST)+wid*2048;
    #pragma unroll
    for(int r=0;r<16;++r){const int orow=crow(r,hi);
      #pragma unroll
      for(int d0=0;d0<2;++d0){ const unsigned pk=cvtpk_s(o[d0][r]*rli[r],0.f); stg[orow*64+d0*32+r32]=(bf16)(pk&0xffffu); } }
    asm volatile("s_waitcnt lgkmcnt(0)":::"memory");
    #pragma unroll
    for(int i=0;i<4;++i){const int row=i*8+(lane>>3),ch=lane&7; const u32x4 v=*(const u32x4*)(stg+row*64+ch*8); *(u32x4*)(Ow+(long)row*PO+ch*8)=v;} }
  asm volatile("s_waitcnt lgkmcnt(0)\n\ts_barrier":::"memory");
  #undef DMA_K
  #undef DMA_V
  #undef MLOAD
  #undef ROT
}
constexpr int ATTN_LDS_BYTES=LDS_BYTES;
#undef SBAR
#undef WAIT_BAR
#undef WAIT_BAR_M
#undef MBIT
#undef MEXP
}
constexpr int NWAVES = 8;
constexpr int N_LAUNCHES = MK_N_LAUNCHES;
constexpr int N_PHASES = 11;

constexpr int DMODEL = 1024, NBATCH = 4, SEQL = 4096, MTOK = NBATCH * SEQL;
constexpr int INW = 5444, ZW = 5632;
constexpr int ZC_XIN = 0, ZC_GB = 512, ZC_GC = 1024, ZC_Q = 1536, ZC_K = 2048, ZC_V = 2560, ZC_GA = 3072, ZC_GBR = 4096, ZC_QI = 5120, ZC_KI = 5376, ZC_WI = 5440;
constexpr int NEXP = 32, DFF = 1024;
constexpr int MAXSLOT = 65536 + NEXP * 256, MAXTILES = MAXSLOT / 256;
constexpr float EPSN = 1e-6f;
constexpr float C2 = 0.125f * 1.4426950408889634f;

constexpr size_t MiB = 1u << 20;
constexpr size_t WS_CTL = 0, CTL_ZERO_BYTES = 1 * MiB;
constexpr size_t WS_WIN = 2 * MiB;
constexpr size_t WS_PAB = 14 * MiB;
constexpr size_t WS_WO = 16 * MiB;
constexpr size_t WS_WGU = 18 * MiB;
constexpr size_t WS_WD = 146 * MiB;
constexpr size_t WS_H = 210 * MiB;
constexpr size_t WS_Z = 242 * MiB;
constexpr size_t WS_ACT = WS_Z;
constexpr size_t WS_QN = 418 * MiB, WS_KN = 434 * MiB;
constexpr size_t WS_YAB = 450 * MiB;
constexpr size_t WS_MASK = 482 * MiB;
constexpr size_t WS_MRG = 490 * MiB;
constexpr size_t WS_YBUF = 522 * MiB;
constexpr size_t WS_LIST = 666 * MiB;
constexpr size_t WS_TOKER = 668 * MiB;
constexpr size_t WS_TOKG = 669 * MiB;
constexpr size_t WS_H8 = 670 * MiB;
constexpr size_t WS_END = 686 * MiB;
#ifndef MOE_FP8
#define MOE_FP8 1
#endif
#ifndef BG_CONV
#define BG_CONV 1
#endif
constexpr float W8_SCALE = 64.0f; constexpr int W8_SCALE_E8M0 = 0x79797979, ONE_E8M0 = 0x7f7f7f7f;
constexpr int CW_BAR = 4096;
constexpr int CW_ECNT_BASE = 8192;
#ifndef PH_DOUBLE
#define PH_DOUBLE 0
#endif
constexpr int CW_ECNT = CW_ECNT_BASE + 32 * ((PH_DOUBLE >> 7) & 1);
constexpr int CW_MOD = 16384;

constexpr int RING_OFF = 0, RING_BYTES = 131072;
constexpr int LDSCTL_OFF = RING_BYTES, MISC_OFF = LDSCTL_OFF + 320, TAB_OFF = LDSCTL_OFF + 1024;
constexpr int LDS_BYTES = 147456;

#define GAS __attribute__((address_space(1)))
#define LAS __attribute__((address_space(3)))
typedef unsigned short bf16;
typedef unsigned v4u __attribute__((ext_vector_type(4)));
typedef float f32x4 __attribute__((ext_vector_type(4)));
typedef float f32x2 __attribute__((ext_vector_type(2)));
typedef float f32x16 __attribute__((ext_vector_type(16)));
typedef short bf16x8 __attribute__((ext_vector_type(8)));
typedef unsigned long long u64;
#define RLX_AGENT __ATOMIC_RELAXED, __HIP_MEMORY_SCOPE_AGENT
#define LDS_WAIT() asm volatile("s_waitcnt lgkmcnt(0)" ::: "memory")
#define VM_WAIT() asm volatile("s_waitcnt vmcnt(0)" ::: "memory")
__device__ __forceinline__ unsigned pkbf(float lo, float hi) { return pg8::cvt_pk_bf16(lo, hi); }
__device__ __forceinline__ float bflo(unsigned w) { return __uint_as_float(w << 16); }
__device__ __forceinline__ float bfhi(unsigned w) { return __uint_as_float(w & 0xffff0000u); }
__device__ __forceinline__ float bf2f(bf16 h) { return __uint_as_float((unsigned)h << 16); }
__device__ __forceinline__ float wave_sum(float v) {
#pragma unroll
    for (int o = 1; o < 64; o <<= 1) v += __shfl_xor(v, o);
    return v;
}
__device__ __forceinline__ float wave_max(float v) {
#pragma unroll
    for (int o = 1; o < 64; o <<= 1) v = fmaxf(v, __shfl_xor(v, o));
    return v;
}

#define XB_TMO      128
#define XB_XCNT(j)  (256  + 64 * (j))
#define XB_XSUB(j)  (1280 + 64 * (j))
#define XB_XGEN(j)  (2304 + 64 * (j))
#define XB_TOP      3328
#define XB_TOPGEN   3392
#define XCD_BAR_WORDS 3456
#define XB_SPIN_CAP (1u << 18)
__device__ __forceinline__ unsigned xb_ld(unsigned* p)              { return __hip_atomic_load(p, __ATOMIC_RELAXED, __HIP_MEMORY_SCOPE_AGENT); }
__device__ __forceinline__ unsigned xb_add(unsigned* p, unsigned v) { return __hip_atomic_fetch_add(p, v, __ATOMIC_RELAXED, __HIP_MEMORY_SCOPE_AGENT); }
__device__ __forceinline__ unsigned xb_xcc_id() { return (unsigned)__builtin_amdgcn_s_getreg((3 << 11) | 20) & 0xFu; }
#define XB_SPIN(cond, bar) do { unsigned _sp = 0; while (cond) { __builtin_amdgcn_s_sleep(1); \
    if ((++_sp & 255u) == 0u) { if (xb_ld(&(bar)[XB_TMO])) break; if (_sp > XB_SPIN_CAP) { atomicAdd(&(bar)[XB_TMO], 1u); break; } } } } while (0)
struct XcdBarrier { unsigned* bar; unsigned x; volatile LAS unsigned* st; };
__device__ __forceinline__ XcdBarrier xcd_barrier_post(unsigned* bar, volatile LAS unsigned* st) {
    XcdBarrier b; b.bar = bar; b.x = xb_xcc_id(); b.st = st;
    if (threadIdx.x == 0) (void)xb_add(&bar[XB_XCNT(b.x)], 1u);
    return b;
}
__device__ __forceinline__ void xcd_barrier_complete(unsigned* bar, unsigned x, unsigned& nloc, unsigned& nx) {
    const unsigned G = gridDim.x * gridDim.y * gridDim.z;
    unsigned sum, cnt, mine, sp = 0u;
    for (;;) {
        sum = 0u; cnt = 0u; mine = 0u;
#pragma unroll
        for (unsigned j = 0; j < 16; ++j) { const unsigned c = xb_ld(&bar[XB_XCNT(j)]); sum += c; cnt += (c > 0u) ? 1u : 0u; mine = (j == x) ? c : mine; }
        if (sum == G) break;
        __builtin_amdgcn_s_sleep(1);
        if ((++sp & 255u) == 0u) { if (xb_ld(&bar[XB_TMO])) break; if (sp > XB_SPIN_CAP) { atomicAdd(&bar[XB_TMO], 1u); break; } }
    }
    nloc = mine > 0u ? mine : 1u; nx = cnt > 0u ? cnt : 1u;
}
__device__ __forceinline__ void xcd_barrier(const XcdBarrier& b) {
    asm volatile("s_waitcnt vmcnt(0)" ::: "memory");
    __syncthreads();
    if (threadIdx.x == 0) {
        unsigned* bar = b.bar;
        __builtin_amdgcn_s_waitcnt(0);
        unsigned nloc = b.st[0], nx = b.st[1];
        if (nloc == 0u) { xcd_barrier_complete(bar, b.x, nloc, nx); b.st[0] = nloc; b.st[1] = nx; }
        const unsigned old = xb_add(&bar[XB_XSUB(b.x)], 1u);
        const unsigned gen = old / nloc;
        if (old + 1u == (gen + 1u) * nloc) {
            __builtin_amdgcn_fence(__ATOMIC_RELEASE, "agent");
            asm volatile("s_waitcnt vmcnt(0)" ::: "memory");
            const unsigned og = xb_add(&bar[XB_TOP], 1u);
            const unsigned tg = og / nx;
            if (og + 1u == (tg + 1u) * nx) xb_add(&bar[XB_TOPGEN], 1u);
            else XB_SPIN(xb_ld(&bar[XB_TOPGEN]) == tg, bar);
            __builtin_amdgcn_fence(__ATOMIC_ACQUIRE, "agent");
            xb_add(&bar[XB_XGEN(b.x)], 1u);
            asm volatile("s_waitcnt vmcnt(0)" ::: "memory");
        } else {
            XB_SPIN(xb_ld(&bar[XB_XGEN(b.x)]) == gen, bar);
            __builtin_amdgcn_fence(__ATOMIC_ACQUIRE, "agent");
            asm volatile("s_waitcnt vmcnt(0)" ::: "memory");
        }
    }
    __syncthreads();
}

struct Args { const float* in[19]; float* out; unsigned char* ws; int ph_lo, ph_hi; };
typedef const __attribute__((address_space(4))) Args* kargs_t;
typedef const float* cfptr_t; typedef const __attribute__((address_space(4))) cfptr_t* inarr_t;
__device__ __forceinline__ kargs_t kargs() {
#if defined(__HIP_DEVICE_COMPILE__)
    unsigned long long v = (unsigned long long)__builtin_amdgcn_kernarg_segment_ptr(); asm volatile("" : "+s"(v)); return (kargs_t)v;
#else
    return (kargs_t)0;
#endif
}
struct Frame {
    LAS unsigned char* lds;
    volatile LAS unsigned* MISC;
    int tid, lane, wave, vcu, G, bx;
};
enum { I_X = 0, I_C, I_WADA, I_BADA, I_N1G, I_WIN, I_CONVW, I_QNG, I_KNG, I_WCO, I_WAO, I_WO, I_N2G, I_WR, I_BR, I_WGU, I_BGU, I_WD, I_BD };

__device__ __forceinline__ void ph_adaln(Frame& F) {
    { int t_ = threadIdx.x; asm volatile("" : "+v"(t_)); F.tid = t_; F.lane = t_ & 63; F.wave = __builtin_amdgcn_readfirstlane(t_ >> 6); }
    kargs_t ap = kargs(); inarr_t IN = (inarr_t)ap->in; unsigned char* WS = ap->ws; unsigned* CTL = (unsigned*)(WS + WS_CTL); float* OUT = ap->out; (void)IN; (void)OUT; (void)CTL;
    float* mod = (float*)(CTL + CW_MOD);
    const float* c = IN[I_C]; const float* W = IN[I_WADA]; const float* ba = IN[I_BADA];
    const int gw = F.vcu * NWAVES + F.wave, NGW = F.G * NWAVES;
    for (int it = gw; it < 1536; it += NGW) {
        const int c0 = 4 * it;
        f32x4 acc[4];
#pragma unroll
        for (int b = 0; b < 4; ++b) acc[b] = (f32x4){0.f, 0.f, 0.f, 0.f};
#pragma unroll 4
        for (int i = 0; i < 16; ++i) {
            const int k = 64 * i + F.lane;
            const f32x4 w = *(const f32x4*)(W + (size_t)k * 6144 + c0);
#pragma unroll
            for (int b = 0; b < 4; ++b) { const float cv = c[b * 1024 + k]; const float s = cv * pg8::fast_sigmoid(cv); acc[b] += w * s; }
        }
#pragma unroll
        for (int b = 0; b < 4; ++b) {
            const float a0 = wave_sum(acc[b].x), a1 = wave_sum(acc[b].y), a2 = wave_sum(acc[b].z), a3 = wave_sum(acc[b].w);
            if (F.lane == 0) *(f32x4*)(mod + b * 6144 + c0) = (f32x4){a0 + ba[c0], a1 + ba[c0 + 1], a2 + ba[c0 + 2], a3 + ba[c0 + 3]};
        }
    }
}

__device__ __forceinline__ void tr_item(const float* src, int ldw, int nvalid, bf16* dst, int K, int lane) {
    const int kc = lane >> 3, ng = lane & 7;
    f32x4 v[8];
    const bool ok = 4 * ng < nvalid;
#pragma unroll
    for (int i = 0; i < 8; ++i) v[i] = ok ? *(const f32x4*)(src + (size_t)(8 * kc + i) * ldw + 4 * ng) : (f32x4){0.f, 0.f, 0.f, 0.f};
#pragma unroll
    for (int j = 0; j < 4; ++j) {
        v4u o; o.x = pkbf(v[0][j], v[1][j]); o.y = pkbf(v[2][j], v[3][j]); o.z = pkbf(v[4][j], v[5][j]); o.w = pkbf(v[6][j], v[7][j]);
        *(v4u*)(dst + (size_t)(4 * ng + j) * K + 8 * kc) = o;
    }
}
__device__ __forceinline__ void tr_item8(const float* src, int ldw, unsigned char* dst, int K, int lane, float scale) {
    const int kc = lane >> 3, ng = lane & 7;
    f32x4 v[8];
#pragma unroll
    for (int i = 0; i < 8; ++i) v[i] = *(const f32x4*)(src + (size_t)(8 * kc + i) * ldw + 4 * ng) * scale;
#pragma unroll
    for (int j = 0; j < 4; ++j) {
        f32x2 dummy; (void)dummy;
        const unsigned lo = pg8::pk4_fp8(v[0][j], v[1][j], v[2][j], v[3][j]), hi = pg8::pk4_fp8(v[4][j], v[5][j], v[6][j], v[7][j]);
        *(u64*)(dst + (size_t)(4 * ng + j) * K + 8 * kc) = (u64)lo | ((u64)hi << 32);
    }
}
__device__ __forceinline__ void norm_row_to_bf16(const float* xrow, const float* g, const float* sc, const float* sh, bf16* orow, int lane) {
    const f32x4* xr = (const f32x4*)xrow + lane;
    f32x4 v[4]; float s = 0.f;
#pragma unroll
    for (int j = 0; j < 4; ++j) { v[j] = xr[64 * j]; s += (v[j].x * v[j].x + v[j].y * v[j].y) + (v[j].z * v[j].z + v[j].w * v[j].w); }
    const float rstd = 1.0f / sqrtf(wave_sum(s) * (1.f / 1024.f) + EPSN);
    u64* o8 = (u64*)orow + lane;
#pragma unroll
    for (int j = 0; j < 4; ++j) {
        const f32x4 gv = ((const f32x4*)g)[lane + 64 * j], scv = ((const f32x4*)sc)[lane + 64 * j], shv = ((const f32x4*)sh)[lane + 64 * j];
        const f32x4 y = (v[j] * rstd) * gv * (scv + 1.0f) + shv;
        o8[64 * j] = (u64)pkbf(y.x, y.y) | ((u64)pkbf(y.z, y.w) << 32);
    }
}
__device__ __forceinline__ void ph_prologue(Frame& F) {
    { int t_ = threadIdx.x; asm volatile("" : "+v"(t_)); F.tid = t_; F.lane = t_ & 63; F.wave = __builtin_amdgcn_readfirstlane(t_ >> 6); }
    kargs_t ap = kargs(); inarr_t IN = (inarr_t)ap->in; unsigned char* WS = ap->ws; unsigned* CTL = (unsigned*)(WS + WS_CTL); float* OUT = ap->out; (void)IN; (void)OUT; (void)CTL;
    const int gw = F.vcu * NWAVES + F.wave, NGW = F.G * NWAVES;
    bf16* Win_t = (bf16*)(WS + WS_WIN); bf16* Pab_t = (bf16*)(WS + WS_PAB); bf16* Wo_t = (bf16*)(WS + WS_WO); bf16* Wgu_t = (bf16*)(WS + WS_WGU); bf16* Wd_t = (bf16*)(WS + WS_WD);
    constexpr int I_IN = 16 * 176, I_PA = 8 * 32, I_PB = 8 * 32, I_O = 16 * 32, I_GU = 32 * 16 * 64, I_D = 32 * 16 * 32;
    constexpr int NITEMS = I_IN + I_PA + I_PB + I_O + ((BG_CONV && MOE_FP8) ? 0 : I_GU + I_D);
    for (int it = gw; it < NITEMS; it += NGW) {
        int r = it;
        if (r < I_IN) { const int kb = r / 176, nb = r % 176, n0 = 32 * nb; int c0, nv;
            if (n0 < 3072) { c0 = n0; nv = 32; } else if (n0 < 5120) { c0 = n0 + 324; nv = 32; } else if (n0 < 5440) { c0 = n0 - 2048; nv = 32; } else if (n0 == 5440) { c0 = 3392; nv = 4; } else { c0 = 0; nv = 0; }
            tr_item(IN[I_WIN] + (size_t)(64 * kb) * INW + c0, INW, nv, Win_t + (size_t)n0 * 1024 + 64 * kb, 1024, F.lane); continue; } r -= I_IN;
        if (r < I_PA) { const int kb = r / 32, nb = r % 32; tr_item(IN[I_WCO] + (size_t)(64 * kb) * 1024 + 32 * nb, 1024, 32, Pab_t + (size_t)(32 * nb) * 512 + 64 * kb, 512, F.lane); continue; } r -= I_PA;
        if (r < I_PB) { const int kb = r / 32, nb = r % 32; tr_item(IN[I_WAO] + (size_t)(64 * kb) * 1024 + 32 * nb, 1024, 32, Pab_t + (size_t)(1024 + 32 * nb) * 512 + 64 * kb, 512, F.lane); continue; } r -= I_PB;
        if (r < I_O) { const int kb = r / 32, nb = r % 32; tr_item(IN[I_WO] + (size_t)(64 * kb) * 1024 + 32 * nb, 1024, 32, Wo_t + (size_t)(32 * nb) * 1024 + 64 * kb, 1024, F.lane); continue; } r -= I_O;
        if (r < I_GU) { const int e = r / 1024, q = r % 1024, kb = q / 64, nb = q % 64; const int cn = nb >> 3, bj = (nb >> 2) & 1, sub = nb & 3, c0 = 1024 * bj + 128 * cn + 32 * sub;
            if (MOE_FP8) tr_item8(IN[I_WGU] + ((size_t)e * 1024 + 64 * kb) * 2048 + c0, 2048, (unsigned char*)Wgu_t + ((size_t)e * 2048 + 32 * nb) * 1024 + 64 * kb, 1024, F.lane, W8_SCALE);
            else tr_item(IN[I_WGU] + ((size_t)e * 1024 + 64 * kb) * 2048 + c0, 2048, 32, Wgu_t + ((size_t)e * 2048 + 32 * nb) * 1024 + 64 * kb, 1024, F.lane); continue; } r -= I_GU;
        { const int e = r / 512, q = r % 512, kb = q / 32, nb = q % 32;
            if (MOE_FP8) tr_item8(IN[I_WD] + ((size_t)e * 1024 + 64 * kb) * 1024 + 32 * nb, 1024, (unsigned char*)Wd_t + ((size_t)e * 1024 + 32 * nb) * 1024 + 64 * kb, 1024, F.lane, W8_SCALE);
            else tr_item(IN[I_WD] + ((size_t)e * 1024 + 64 * kb) * 1024 + 32 * nb, 1024, 32, Wd_t + ((size_t)e * 1024 + 32 * nb) * 1024 + 64 * kb, 1024, F.lane); }
    }
    const float* mod = (const float*)(CTL + CW_MOD);
    bf16* H = (bf16*)(WS + WS_H);
    for (int m = gw; m < MTOK; m += NGW) { const float* mb = mod + (size_t)(m >> 12) * 6144;
        norm_row_to_bf16(IN[I_X] + (size_t)m * 1024, IN[I_N1G], mb + 1024, mb, H + (size_t)m * 1024, F.lane); }
}

constexpr int BG_I_GU = 32 * 16 * 64, BG_I_D = 32 * 16 * 32, BG_NITEMS = BG_I_GU + BG_I_D;
struct BgConv { int it, it_end, stride, half; bool pend; unsigned char* dst; f32x4 v[4]; };
__device__ __forceinline__ void bg_step(BgConv& B, int lane) {
    if (B.pend) {
#pragma unroll
        for (int j = 0; j < 4; ++j) *(unsigned*)(B.dst + (size_t)j * 1024) = pg8::pk4_fp8(B.v[0][j] * W8_SCALE, B.v[1][j] * W8_SCALE, B.v[2][j] * W8_SCALE, B.v[3][j] * W8_SCALE);
    }
    if (B.it < B.it_end) {
        kargs_t ap = kargs(); inarr_t IN = (inarr_t)ap->in; unsigned char* WS = ap->ws;
        const int kc = lane >> 3, ng = lane & 7; int r = B.it; const float* src; int ldw; unsigned char* dst;
        if (r < BG_I_GU) { const int e = r / 1024, q = r % 1024, kb = q / 64, nb = q % 64; const int cn = nb >> 3, bj = (nb >> 2) & 1, sub = nb & 3, c0 = 1024 * bj + 128 * cn + 32 * sub;
            src = IN[I_WGU] + ((size_t)e * 1024 + 64 * kb) * 2048 + c0; ldw = 2048; dst = WS + WS_WGU + ((size_t)e * 2048 + 32 * nb) * 1024 + 64 * kb; }
        else { r -= BG_I_GU; const int e = r / 512, q = r % 512, kb = q / 32, nb = q % 32;
            src = IN[I_WD] + ((size_t)e * 1024 + 64 * kb) * 1024 + 32 * nb; ldw = 1024; dst = WS + WS_WD + ((size_t)e * 1024 + 32 * nb) * 1024 + 64 * kb; }
#pragma unroll
        for (int i = 0; i < 4; ++i) B.v[i] = *(const f32x4*)(src + (size_t)(8 * kc + 4 * B.half + i) * ldw + 4 * ng);
        B.dst = dst + (size_t)(4 * ng) * 1024 + 8 * kc + 4 * B.half; B.pend = true;
        if (B.half) { B.it += B.stride; B.half = 0; } else B.half = 1;
    } else B.pend = false;
}
constexpr int SEL_CAP = 64;
constexpr int CW_ERR = 12400;
#ifndef DBG_SELCHK
#define DBG_SELCHK 0
#endif
template <bool FAST>
__device__ __forceinline__ void sel_unit(Frame& F, int b, int j, int hf, bool check, BgConv& bg) {
    { int t_ = threadIdx.x; asm volatile("" : "+v"(t_)); F.tid = t_; F.lane = t_ & 63; F.wave = __builtin_amdgcn_readfirstlane(t_ >> 6); }
    kargs_t ap = kargs(); unsigned char* WS = ap->ws; unsigned* CTL = (unsigned*)(WS + WS_CTL); (void)CTL;
    LAS unsigned* hist = (LAS unsigned*)(F.lds);
    LAS unsigned* mgt = (LAS unsigned*)(F.lds + 32768);
    LAS unsigned* meq = (LAS unsigned*)(F.lds + 49152);
    LAS unsigned* part = (LAS unsigned*)(F.lds + 65536);
    LAS unsigned* st = (LAS unsigned*)(F.lds + 67584);
    LAS unsigned* lst = (LAS unsigned*)(F.lds + 69632);
    const int tid = F.tid, lane = F.lane, wid = F.wave, r = lane & 31, hi = lane >> 5;
    const int N = 64 * (j + 1), nkt = N / 32, tmax = 4 * (j / 4) + 3;
    const bf16* Z = (const bf16*)(WS + WS_Z);
    u64* mout = (u64*)(WS + WS_MASK) + (size_t)b * 64 * SEQL + (64 * j + 32 * hf);
    if (N <= 256) {
        if (!check) for (int idx = tid; idx < (tmax + 1) * 32; idx += 512) { const int tile = idx >> 5, q = idx & 31; mout[(size_t)tile * SEQL + q] = tile <= j ? ~0ull : 0ull; }
        return;
    }
    for (int i = tid; i < 16384; i += 512) hist[i] = 0u;
    if (tid < 32) { st[tid] = 0u; st[32 + tid] = 256u; st[64 + tid] = 0u; st[96 + tid] = 0u; }
    if (tid == 0) st[128] = 0u;
    const bf16* qrow = Z + (size_t)(b * SEQL + 64 * j + 32 * hf + r) * ZW;
    bf16x8 qf[4][4]; float wq[4];
#pragma unroll
    for (int h = 0; h < 4; ++h) {
#pragma unroll
        for (int ks = 0; ks < 4; ++ks) qf[h][ks] = *(const bf16x8*)(qrow + ZC_QI + 64 * h + 16 * ks + 8 * hi);
        wq[h] = bf2f(qrow[ZC_WI + h]) * 0.0625f;
    }
    const bf16* kbase = Z + (size_t)(b * SEQL + r) * ZW + ZC_KI + 8 * hi;
    __syncthreads();
    constexpr int NPASS = FAST ? 3 : 5, NHIST = FAST ? 2 : 4;
    for (int pass = 0; pass < NPASS; ++pass) {
        const int shift = 24 - 8 * pass;
        const unsigned prefix = st[r];
        const unsigned himask = pass == 0 ? 0u : (pass >= 4 ? 0xffffffffu : (0xffffffffu << (shift + 8)));
        bf16x8 kfn[4];
        if (wid < nkt) {
#pragma unroll
            for (int ks = 0; ks < 4; ++ks) kfn[ks] = *(const bf16x8*)(kbase + (size_t)(32 * wid) * ZW + 16 * ks); }
        for (int kt = wid; kt < nkt; kt += 8) {
            if (BG_CONV) bg_step(bg, lane);
            bf16x8 kf[4];
#pragma unroll
            for (int ks = 0; ks < 4; ++ks) kf[ks] = kfn[ks];
            if (kt + 8 < nkt) {
#pragma unroll
                for (int ks = 0; ks < 4; ++ks) kfn[ks] = *(const bf16x8*)(kbase + (size_t)(32 * (kt + 8)) * ZW + 16 * ks); }
            float sc[16];
#pragma unroll
            for (int g = 0; g < 16; ++g) sc[g] = 0.f;
#pragma unroll
            for (int h = 0; h < 4; ++h) {
                f32x16 acc = {};
#pragma unroll
                for (int ks = 0; ks < 4; ++ks) acc = __builtin_amdgcn_mfma_f32_32x32x16_bf16(kf[ks], qf[h][ks], acc, 0, 0, 0);
#pragma unroll
                for (int g = 0; g < 16; ++g) { const int ib = (int)__float_as_uint(acc[g]); const float rl = __uint_as_float((unsigned)(ib > 0 ? ib : 0)); sc[g] = __builtin_fmaf(wq[h], rl, sc[g]); }
            }
            unsigned key[16];
#pragma unroll
            for (int g = 0; g < 16; ++g) { const unsigned u = __float_as_uint(sc[g]); key[g] = u ^ ((unsigned)((int)u >> 31) | 0x80000000u); }
            if (pass == 0) {
#pragma unroll
                for (int g = 0; g < 16; ++g) __hip_atomic_fetch_add(hist + (key[g] >> 24) * 32 + r, 1u, __ATOMIC_RELAXED, __HIP_MEMORY_SCOPE_WORKGROUP);
            } else if (pass < NHIST) {
#pragma unroll
                for (int g = 0; g < 16; ++g) {
                    if (((key[g] ^ prefix) & himask) == 0u) __hip_atomic_fetch_add(hist + __builtin_amdgcn_ubfe(key[g], (unsigned)shift, 8u) * 32 + r, 1u, __ATOMIC_RELAXED, __HIP_MEMORY_SCOPE_WORKGROUP); }
            } else if (FAST) {
                const unsigned p16 = prefix >> 16;
                unsigned bg = 0u, bz = 0u;
#pragma unroll
                for (int g = 0; g < 16; ++g) { const unsigned pos = (unsigned)((g & 3) + 8 * (g >> 2)); const unsigned h16 = key[g] >> 16;
                    bg |= (h16 > p16 ? 1u : 0u) << pos;
                    if (h16 == p16) { const unsigned low = key[g] & 0xffffu;
                        if (low == 0u) bz |= 1u << pos;
                        else { const unsigned slot = __hip_atomic_fetch_add(st + 96 + r, 1u, __ATOMIC_RELAXED, __HIP_MEMORY_SCOPE_WORKGROUP);
                            if (slot < (unsigned)SEL_CAP) lst[r * SEL_CAP + slot] = (low << 12) | (4095u - (unsigned)(kt * 32 + (int)pos + 4 * hi)); } } }
                bg <<= 4 * hi; bz <<= 4 * hi;
                __hip_atomic_fetch_or(mgt + kt * 32 + r, bg, __ATOMIC_RELAXED, __HIP_MEMORY_SCOPE_WORKGROUP);
                if (bz) __hip_atomic_fetch_or(meq + kt * 32 + r, bz, __ATOMIC_RELAXED, __HIP_MEMORY_SCOPE_WORKGROUP);
            } else {
                unsigned bg = 0u, be = 0u;
#pragma unroll
                for (int g = 0; g < 16; ++g) { const unsigned pos = (unsigned)((g & 3) + 8 * (g >> 2));
                    bg |= (key[g] > prefix ? 1u : 0u) << pos; be |= (key[g] == prefix ? 1u : 0u) << pos; }
                bg <<= 4 * hi; be <<= 4 * hi;
                __hip_atomic_fetch_or(mgt + kt * 32 + r, bg, __ATOMIC_RELAXED, __HIP_MEMORY_SCOPE_WORKGROUP);
                __hip_atomic_fetch_or(meq + kt * 32 + r, be, __ATOMIC_RELAXED, __HIP_MEMORY_SCOPE_WORKGROUP);
            }
        }
        __syncthreads();
        if (pass < NHIST) {
            const int q = tid & 31, g = tid >> 5;
            unsigned c[16], sum = 0u;
#pragma unroll
            for (int i = 0; i < 16; ++i) { c[i] = hist[(16 * g + i) * 32 + q]; sum += c[i]; hist[(16 * g + i) * 32 + q] = 0u; }
            part[g * 32 + q] = sum;
            const unsigned kr = st[32 + q];
            __syncthreads();
            unsigned above = 0u;
            for (int gg = g + 1; gg < 16; ++gg) above += part[gg * 32 + q];
            if (above < kr && kr <= above + sum) {
                unsigned cum = above; int dig = 16 * g; unsigned ce = 0u;
#pragma unroll
                for (int i = 15; i >= 0; --i) { if (cum < kr && kr <= cum + c[i]) { dig = 16 * g + i; ce = c[i]; st[32 + q] = kr - cum; } cum += c[i]; }
                st[q] |= (unsigned)dig << shift; st[64 + q] = ce;
            }
            __syncthreads();
        }
    }
    const int q = tid & 31, g = tid >> 5;
    if (FAST) {
        const unsigned kr = st[32 + q], nl = st[96 + q];
        if (nl > (unsigned)SEL_CAP) st[128] = 1u;
        const unsigned n = nl < (unsigned)SEL_CAP ? nl : (unsigned)SEL_CAP;
        for (unsigned i = g; i < n; i += 16) { const unsigned sk = lst[q * SEL_CAP + i]; unsigned rank = 0u;
            for (unsigned jj = 0; jj < n; ++jj) rank += lst[q * SEL_CAP + jj] > sk ? 1u : 0u;
            if (rank < kr) { const unsigned pos = 4095u - (sk & 4095u); __hip_atomic_fetch_or(mgt + (pos >> 5) * 32 + q, 1u << (pos & 31u), __ATOMIC_RELAXED, __HIP_MEMORY_SCOPE_WORKGROUP); } }
        if (kr > n && g == 0) { const unsigned need = kr - n; unsigned taken = 0u;
            for (int kt = 0; kt < nkt && taken < need; ++kt) { unsigned w = meq[kt * 32 + q]; if (!w) continue; const unsigned cnt = __popc(w);
                if (taken + cnt > need) { unsigned keep = 0u; unsigned left = need - taken; while (left) { const unsigned lb = w & (0u - w); keep |= lb; w ^= lb; --left; } w = keep; taken = need; } else taken += cnt;
                __hip_atomic_fetch_or(mgt + kt * 32 + q, w, __ATOMIC_RELAXED, __HIP_MEMORY_SCOPE_WORKGROUP); } }
    } else {
        const unsigned need = st[32 + q], ce = st[64 + q];
        if (ce > need) {
            if (g == 0) { unsigned taken = 0u;
                for (int kt = 0; kt < nkt; ++kt) { unsigned w = meq[kt * 32 + q]; const unsigned cnt = __popc(w);
                    if (taken + cnt > need) { unsigned keep = 0u; unsigned left = need - taken; while (left) { const unsigned lb = w & (0u - w); keep |= lb; w ^= lb; --left; } w = keep; taken = need; } else taken += cnt;
                    mgt[kt * 32 + q] |= w; } }
        } else {
            for (int kt = g; kt < nkt; kt += 16) mgt[kt * 32 + q] |= meq[kt * 32 + q];
        }
    }
    __syncthreads();
    const bool overflow = FAST && st[128] != 0u;
    if (!overflow) {
        for (int tile = g; tile <= tmax; tile += 16) {
            const unsigned lo = 2 * tile < nkt ? mgt[(2 * tile) * 32 + q] : 0u, hw = 2 * tile + 1 < nkt ? mgt[(2 * tile + 1) * 32 + q] : 0u;
            const u64 w = (u64)lo | ((u64)hw << 32);
            if (check) { if (mout[(size_t)tile * SEQL + q] != w) atomicAdd(CTL + CW_ERR, 1u); }
            else mout[(size_t)tile * SEQL + q] = w;
        }
    }
    __syncthreads();
    if constexpr (FAST) { if (overflow) sel_unit<false>(F, b, j, hf, check, bg); }
}
__device__ __forceinline__ void ph_select(Frame& F) {
    { int t_ = threadIdx.x; asm volatile("" : "+v"(t_)); F.tid = t_; F.lane = t_ & 63; F.wave = __builtin_amdgcn_readfirstlane(t_ >> 6); }
    kargs_t ap = kargs(); inarr_t IN = (inarr_t)ap->in; unsigned char* WS = ap->ws; unsigned* CTL = (unsigned*)(WS + WS_CTL); float* OUT = ap->out; (void)IN; (void)OUT; (void)CTL;
    for (int rep_ = 0; rep_ < 1 + ((PH_DOUBLE >> 11) & 1); ++rep_) {
        const bf16* Z = (const bf16*)(WS + WS_Z);
        bf16* Qn = (bf16*)(WS + WS_QN); bf16* Kn = (bf16*)(WS + WS_KN); bf16* YA = (bf16*)(WS + WS_YAB);
        const int lane = F.lane, d0 = (8 * lane) & 63, c0 = 8 * lane;
        float gq[8], gk[8], w0[8], w1[8], w2[8];
#pragma unroll
        for (int i = 0; i < 8; ++i) { gq[i] = IN[I_QNG][d0 + i] * C2; gk[i] = IN[I_KNG][d0 + i]; w0[i] = IN[I_CONVW][c0 + i]; w1[i] = IN[I_CONVW][512 + c0 + i]; w2[i] = IN[I_CONVW][1024 + c0 + i]; }
        for (int tb = F.vcu; tb < MTOK / 64; tb += F.G) {
            const int tok0 = tb * 64 + 8 * F.wave;
            float um2[8], um1[8];
#pragma unroll
            for (int k = 0; k < 2; ++k) { const int tk = tok0 - 2 + k; float* dst = k == 0 ? um2 : um1;
                if ((tok0 & (SEQL - 1)) >= 2 - k) { const bf16* zr = Z + (size_t)tk * ZW; const v4u xi = *(const v4u*)(zr + ZC_XIN + c0), gc = *(const v4u*)(zr + ZC_GC + c0);
                    dst[0] = bflo(xi.x) * bflo(gc.x); dst[1] = bfhi(xi.x) * bfhi(gc.x); dst[2] = bflo(xi.y) * bflo(gc.y); dst[3] = bfhi(xi.y) * bfhi(gc.y);
                    dst[4] = bflo(xi.z) * bflo(gc.z); dst[5] = bfhi(xi.z) * bfhi(gc.z); dst[6] = bflo(xi.w) * bflo(gc.w); dst[7] = bfhi(xi.w) * bfhi(gc.w); }
                else {
#pragma unroll
                    for (int i = 0; i < 8; ++i) dst[i] = 0.f; } }
            for (int i = 0; i < 8; ++i) {
                const int tok = tok0 + i; const bf16* zr = Z + (size_t)tok * ZW;
                const v4u xi = *(const v4u*)(zr + ZC_XIN + c0), gc = *(const v4u*)(zr + ZC_GC + c0), gb = *(const v4u*)(zr + ZC_GB + c0), qv = *(const v4u*)(zr + ZC_Q + c0), kv = *(const v4u*)(zr + ZC_K + c0);
                float u[8] = {bflo(xi.x) * bflo(gc.x), bfhi(xi.x) * bfhi(gc.x), bflo(xi.y) * bflo(gc.y), bfhi(xi.y) * bfhi(gc.y), bflo(xi.z) * bflo(gc.z), bfhi(xi.z) * bfhi(gc.z), bflo(xi.w) * bflo(gc.w), bfhi(xi.w) * bfhi(gc.w)};
                const float gbf[8] = {bflo(gb.x), bfhi(gb.x), bflo(gb.y), bfhi(gb.y), bflo(gb.z), bfhi(gb.z), bflo(gb.w), bfhi(gb.w)};
                float y[8];
#pragma unroll
                for (int k = 0; k < 8; ++k) { y[k] = gbf[k] * (w0[k] * um2[k] + w1[k] * um1[k] + w2[k] * u[k]); um2[k] = um1[k]; um1[k] = u[k]; }
                if ((tok & (SEQL - 1)) == 0) {
                }
                *(v4u*)(YA + (size_t)tok * 512 + c0) = (v4u){pkbf(y[0], y[1]), pkbf(y[2], y[3]), pkbf(y[4], y[5]), pkbf(y[6], y[7])};
                float qf_[8] = {bflo(qv.x), bfhi(qv.x), bflo(qv.y), bfhi(qv.y), bflo(qv.z), bfhi(qv.z), bflo(qv.w), bfhi(qv.w)};
                float kf_[8] = {bflo(kv.x), bfhi(kv.x), bflo(kv.y), bfhi(kv.y), bflo(kv.z), bfhi(kv.z), bflo(kv.w), bfhi(kv.w)};
                float sq = 0.f, sk = 0.f;
#pragma unroll
                for (int k = 0; k < 8; ++k) { sq += qf_[k] * qf_[k]; sk += kf_[k] * kf_[k]; }
                sq += __shfl_xor(sq, 1); sk += __shfl_xor(sk, 1); sq += __shfl_xor(sq, 2); sk += __shfl_xor(sk, 2); sq += __shfl_xor(sq, 4); sk += __shfl_xor(sk, 4);
                const float rq = 1.0f / sqrtf(sq * (1.f / 64.f) + EPSN), rk = 1.0f / sqrtf(sk * (1.f / 64.f) + EPSN);
#pragma unroll
                for (int k = 0; k < 8; ++k) { qf_[k] = qf_[k] * rq * gq[k]; kf_[k] = kf_[k] * rk * gk[k]; }
                *(v4u*)(Qn + (size_t)tok * 512 + c0) = (v4u){pkbf(qf_[0], qf_[1]), pkbf(qf_[2], qf_[3]), pkbf(qf_[4], qf_[5]), pkbf(qf_[6], qf_[7])};
                *(v4u*)(Kn + (size_t)tok * 512 + c0) = (v4u){pkbf(kf_[0], kf_[1]), pkbf(kf_[2], kf_[3]), pkbf(kf_[4], kf_[5]), pkbf(kf_[6], kf_[7])};
            }
        }
    }
    BgConv bg; bg.it = F.vcu * NWAVES + F.wave; bg.it_end = (BG_CONV && MOE_FP8) ? BG_NITEMS : 0; bg.stride = F.G * NWAVES; bg.half = 0; bg.pend = false; bg.dst = nullptr;
    for (int rep_ = 0; rep_ < 1 + ((PH_DOUBLE >> 12) & 1); ++rep_)
    for (int v = F.vcu; v < 256; v += F.G) {
        const int b = v & 3, hf = (v >> 2) & 1, s = v >> 3;
        if (DBG_SELCHK) { sel_unit<false>(F, b, 63 - s, hf, false, bg); sel_unit<false>(F, b, s, hf, false, bg); __threadfence(); __syncthreads(); sel_unit<true>(F, b, 63 - s, hf, true, bg); sel_unit<true>(F, b, s, hf, true, bg); }
        else { sel_unit<true>(F, b, 63 - s, hf, false, bg); sel_unit<true>(F, b, s, hf, false, bg); }
    }
    while (bg.pend || bg.it < bg.it_end) bg_step(bg, F.lane);
}

__device__ __forceinline__ void ph_router(Frame& F, int rep) {
    { int t_ = threadIdx.x; asm volatile("" : "+v"(t_)); F.tid = t_; F.lane = t_ & 63; F.wave = __builtin_amdgcn_readfirstlane(t_ >> 6); }
    kargs_t ap = kargs(); inarr_t IN = (inarr_t)ap->in; unsigned char* WS = ap->ws; unsigned* CTL = (unsigned*)(WS + WS_CTL); float* OUT = ap->out; (void)IN; (void)OUT; (void)CTL;
    LAS f32x4* Wl = (LAS f32x4*)(F.lds);
    LAS unsigned* lcnt = (LAS unsigned*)(F.lds + TAB_OFF);
    LAS unsigned* lbase = lcnt + 32;
    LAS unsigned* ler = lcnt + 64;
    LAS float* lgate = (LAS float*)(lcnt + 64 + 256);
    const float* WR = IN[I_WR]; const float* BR = IN[I_BR];
    const float* mod = (const float*)(CTL + CW_MOD);
    bf16* H = (bf16*)(WS + WS_H);
    int* list = (int*)(WS + WS_LIST); unsigned* toker = (unsigned*)(WS + WS_TOKER); float* tokg = (float*)(WS + WS_TOKG);
    unsigned* gcnt = CTL + CW_ECNT_BASE + 32 * rep;
    const int lane = F.lane;
    for (int idx = F.tid; idx < 8192; idx += 512) { const int l = idx & 63, q = (idx >> 6) & 7, c = (idx >> 9) & 3, j = idx >> 11;
        Wl[idx] = *(const f32x4*)(WR + (size_t)(4 * l + c + 256 * j) * 32 + 4 * q); }
    const int ebit = ((lane >> 5) & 1) * 16 + ((lane >> 4) & 1) * 8 + ((lane >> 3) & 1) * 4 + ((lane >> 2) & 1) * 2 + ((lane >> 1) & 1);
    const float myb = BR[ebit];
    for (int tb = F.vcu; tb < MTOK / 64; tb += F.G) {
        if (F.tid < 32) lcnt[F.tid] = 0u;
        __syncthreads();
        for (int i = 0; i < 8; ++i) {
            const int tl = 8 * F.wave + i, tok = tb * 64 + tl;
            const float* mb = mod + (size_t)(tok >> 12) * 6144;
            const f32x4* xr = (const f32x4*)(OUT + (size_t)tok * 1024) + lane;
            f32x4 v[4]; float s = 0.f;
#pragma unroll
            for (int j = 0; j < 4; ++j) { v[j] = xr[64 * j]; s += (v[j].x * v[j].x + v[j].y * v[j].y) + (v[j].z * v[j].z + v[j].w * v[j].w); }
            const float rstd = 1.0f / sqrtf(wave_sum(s) * (1.f / 1024.f) + EPSN);
            u64* o8 = (u64*)(H + (size_t)tok * 1024) + lane;
            float acc[32];
#pragma unroll
            for (int e = 0; e < 32; ++e) acc[e] = 0.f;
#pragma unroll
            for (int j = 0; j < 4; ++j) {
                const f32x4 gv = ((const f32x4*)IN[I_N2G])[lane + 64 * j], scv = ((const f32x4*)(mb + 4096))[lane + 64 * j], shv = ((const f32x4*)(mb + 3072))[lane + 64 * j];
                const f32x4 y = (v[j] * rstd) * gv * (scv + 1.0f) + shv;
                if (MOE_FP8) ((unsigned*)(WS + WS_H8 + (size_t)tok * 1024))[lane + 64 * j] = pg8::pk4_fp8(y.x, y.y, y.z, y.w);
                else o8[64 * j] = (u64)pkbf(y.x, y.y) | ((u64)pkbf(y.z, y.w) << 32);
#pragma unroll
                for (int c = 0; c < 4; ++c) { const float hv = y[c];
#pragma unroll
                    for (int q = 0; q < 8; ++q) { const f32x4 w = Wl[((j * 4 + c) * 8 + q) * 64 + lane]; acc[4 * q] += hv * w.x; acc[4 * q + 1] += hv * w.y; acc[4 * q + 2] += hv * w.z; acc[4 * q + 3] += hv * w.w; } }
            }
#pragma unroll
            for (int i2 = 0; i2 < 16; ++i2) { const bool up = lane & 32; const float send = up ? acc[i2] : acc[i2 + 16], keep = up ? acc[i2 + 16] : acc[i2]; acc[i2] = keep + __shfl_xor(send, 32); }
#pragma unroll
            for (int i2 = 0; i2 < 8; ++i2) { const bool up = lane & 16; const float send = up ? acc[i2] : acc[i2 + 8], keep = up ? acc[i2 + 8] : acc[i2]; acc[i2] = keep + __shfl_xor(send, 16); }
#pragma unroll
            for (int i2 = 0; i2 < 4; ++i2) { const bool up = lane & 8; const float send = up ? acc[i2] : acc[i2 + 4], keep = up ? acc[i2 + 4] : acc[i2]; acc[i2] = keep + __shfl_xor(send, 8); }
#pragma unroll
            for (int i2 = 0; i2 < 2; ++i2) { const bool up = lane & 4; const float send = up ? acc[i2] : acc[i2 + 2], keep = up ? acc[i2 + 2] : acc[i2]; acc[i2] = keep + __shfl_xor(send, 4); }
            { const bool up = lane & 2; const float send = up ? acc[0] : acc[1], keep = up ? acc[1] : acc[0]; acc[0] = keep + __shfl_xor(send, 2); }
            float logit = acc[0] + __shfl_xor(acc[0], 1) + myb;
            float tv[4]; int te[4];
            unsigned lu = __float_as_uint(logit); unsigned lkey = lu ^ ((unsigned)((int)lu >> 31) | 0x80000000u);
#pragma unroll
            for (int k = 0; k < 4; ++k) {
                u64 best = ((u64)lkey << 32) | (unsigned)(31 - ebit);
#pragma unroll
                for (int o = 1; o < 64; o <<= 1) { const unsigned bh = __shfl_xor((unsigned)(best >> 32), o), bl = __shfl_xor((unsigned)best, o); const u64 ot = ((u64)bh << 32) | bl; best = ot > best ? ot : best; }
                const int we = 31 - (int)(unsigned)best; te[k] = we;
                const unsigned wk = (unsigned)(best >> 32); const unsigned wu = (wk & 0x80000000u) ? (wk ^ 0x80000000u) : ~wk; tv[k] = __uint_as_float(wu);
                if (ebit == we) lkey = 0u;
            }
            const float e1 = expf(tv[1] - tv[0]), e2 = expf(tv[2] - tv[0]), e3 = expf(tv[3] - tv[0]); const float inv = 1.0f / (1.0f + e1 + e2 + e3);
            if (lane < 4) { const int e = lane == 0 ? te[0] : lane == 1 ? te[1] : lane == 2 ? te[2] : te[3]; const float g = (lane == 0 ? 1.0f : lane == 1 ? e1 : lane == 2 ? e2 : e3) * inv;
                const unsigned lr = __hip_atomic_fetch_add(lcnt + e, 1u, __ATOMIC_RELAXED, __HIP_MEMORY_SCOPE_WORKGROUP);
                ler[tl * 4 + lane] = (unsigned)e | (lr << 8); lgate[tl * 4 + lane] = g; }
        }
        __syncthreads();
        if (F.tid < 32) lbase[F.tid] = __hip_atomic_fetch_add(gcnt + F.tid, lcnt[F.tid], RLX_AGENT);
        __syncthreads();
        if (F.tid < 256) { const unsigned er = ler[F.tid]; const int e = er & 255u; const unsigned rank = lbase[e] + (er >> 8); const int tok = tb * 64 + (F.tid >> 2);
            list[(size_t)e * MTOK + rank] = tok; toker[(size_t)tok * 4 + (F.tid & 3)] = (unsigned)e | (rank << 8); tokg[(size_t)tok * 4 + (F.tid & 3)] = lgate[F.tid]; }
        __syncthreads();
    }
}

__device__ __forceinline__ void moe_table(Frame& F) {
    { int t_ = threadIdx.x; asm volatile("" : "+v"(t_)); F.tid = t_; F.lane = t_ & 63; F.wave = __builtin_amdgcn_readfirstlane(t_ >> 6); }
    kargs_t ap = kargs(); inarr_t IN = (inarr_t)ap->in; unsigned char* WS = ap->ws; unsigned* CTL = (unsigned*)(WS + WS_CTL); float* OUT = ap->out; (void)IN; (void)OUT; (void)CTL;
    LAS int* tab = (LAS int*)(F.lds + TAB_OFF);
    if (F.tid == 0) { int nt = 0;
        for (int e = 0; e < NEXP; ++e) { const int c = (int)__hip_atomic_load(CTL + CW_ECNT + e, RLX_AGENT); tab[512 + e] = c; const int n = (c + 255) >> 8; for (int r = 0; r < n; ++r) tab[1 + nt++] = e | (r << 8); }
        tab[0] = nt; }
    __syncthreads();
}
struct MoeOrder {
    const LAS int* tab; int ncol, G, c; const int* list;
    __device__ __forceinline__ bool next(int i, pg8::Unit& u) const {
        const int nM = tab[0], nN = ncol, nwg = nM * nN; const long L = (long)i * G + c; if (L >= nwg) return false;
        int wgid = (int)L; { const int q = nwg / 8, r = nwg % 8, xcd = wgid % 8, off = wgid / 8; wgid = (xcd < r ? xcd * (q + 1) : r * (q + 1) + (xcd - r) * q) + off; }
        const int nig = 8 * nN, gid = wgid / nig, fm = gid * 8, gsz = (nM - fm) < 8 ? (nM - fm) : 8;
        const int pm = fm + ((wgid % nig) % gsz), cn = (wgid % nig) / gsz; const int er = tab[1 + pm];
        u.pm = pm; u.e = er & 255; u.r = er >> 8; u.pn = u.e * ncol + cn; return true;
    }
    __device__ __forceinline__ const int* rows(const pg8::Unit& u, int& cnt) const { cnt = tab[512 + u.e]; return list + (size_t)u.e * MTOK; }
};
struct MergeOrder {
    pg8::StaticOrder so;
    __device__ __forceinline__ bool next(int i, pg8::Unit& u) const { if (!so.next(i >> 1, u)) return false; if (i & 1) { u.pm += 64; u.pn += 4; } return true; }
    __device__ __forceinline__ const int* rows(const pg8::Unit&, int& cnt) const { cnt = 0; return nullptr; }
};

#ifndef DBG_NPH
#define DBG_NPH 11
#endif
__device__ __forceinline__ void ph_combine(Frame& F, bool dummy) {
    { int t_ = threadIdx.x; asm volatile("" : "+v"(t_)); F.tid = t_; F.lane = t_ & 63; F.wave = __builtin_amdgcn_readfirstlane(t_ >> 6); }
    kargs_t ap = kargs(); inarr_t IN = (inarr_t)ap->in; unsigned char* WS = ap->ws; unsigned* CTL = (unsigned*)(WS + WS_CTL); float* OUT = ap->out; (void)IN; (void)OUT; (void)CTL;
    LAS int* tab = (LAS int*)(F.lds + TAB_OFF);
    if (F.tid == 0) { int acc = 0; for (int e = 0; e < NEXP; ++e) { tab[e] = acc; const int c = (int)__hip_atomic_load(CTL + CW_ECNT + e, RLX_AGENT); acc += ((c + 255) >> 8) << 8; } }
    __syncthreads();
    const float* mod = (const float*)(CTL + CW_MOD);
    const bf16* Y = (const bf16*)(WS + (DBG_NPH == 9 ? WS_ACT : WS_YBUF)); const unsigned* toker = (const unsigned*)(WS + WS_TOKER); const float* tokg = (const float*)(WS + WS_TOKG);
    const int gw = F.vcu * NWAVES + F.wave, NGW = F.G * NWAVES, lane = F.lane;
    for (int tok = gw; tok < MTOK; tok += NGW) {
        const float* g2 = mod + (size_t)(tok >> 12) * 6144 + 5120;
        f32x4 a[4];
#pragma unroll
        for (int j = 0; j < 4; ++j) a[j] = (f32x4){0.f, 0.f, 0.f, 0.f};
#pragma unroll
        for (int k = 0; k < 4; ++k) { const unsigned er = toker[(size_t)tok * 4 + k]; const float g = tokg[(size_t)tok * 4 + k]; const int slot = tab[er & 255u] + (int)(er >> 8);
            const u64* yr = (const u64*)(Y + (size_t)slot * 1024) + lane;
            float gg = g; if (DBG_NPH == 8) { yr = (const u64*)((const bf16*)(WS + WS_H) + (size_t)tok * 1024) + lane; gg = g * (float)((er & 255u) + 1u) * 0.0625f; }
#pragma unroll
            for (int j = 0; j < 4; ++j) { const u64 w = yr[64 * j]; const unsigned lo = (unsigned)w, hi = (unsigned)(w >> 32); a[j].x += gg * bflo(lo); a[j].y += gg * bfhi(lo); a[j].z += gg * bflo(hi); a[j].w += gg * bfhi(hi); } }
        if (DBG_SELCHK && __hip_atomic_load(CTL + CW_ERR, RLX_AGENT) != 0u) a[0].x += 1000.0f;
        f32x4* orow = (f32x4*)(OUT + (size_t)tok * 1024) + lane; f32x4* wrow = dummy ? (f32x4*)((float*)(WS + WS_ACT) + (size_t)tok * 1024) + lane : orow;
#pragma unroll
        for (int j = 0; j < 4; ++j) { const f32x4 gv = ((const f32x4*)g2)[lane + 64 * j]; wrow[64 * j] = orow[64 * j] + gv * a[j]; }
    }
}


constexpr int CW_HASH = 12288;
#ifndef DBG_HMASK
#define DBG_HMASK 0x3ff
#endif
__device__ __forceinline__ void dbg_hash(Frame& F) {
    { int t_ = threadIdx.x; asm volatile("" : "+v"(t_)); F.tid = t_; F.lane = t_ & 63; F.wave = __builtin_amdgcn_readfirstlane(t_ >> 6); }
    kargs_t ap = kargs(); unsigned char* WS = ap->ws; unsigned* CTL = (unsigned*)(WS + WS_CTL);
    const size_t offs[10] = {WS_CTL + (size_t)CW_MOD * 4, WS_WIN, WS_H, WS_Z, WS_QN, WS_YAB, WS_MASK, WS_YAB + (size_t)MTOK * 1024, WS_MRG, 0};
    const size_t lens[10] = {24576 * 4, 208 * MiB, 32 * MiB, 176 * MiB, 32 * MiB, 16 * MiB, 8 * MiB, 16 * MiB, 32 * MiB, 64 * MiB};
    for (int k = 0; k < 10; ++k) {
        const unsigned* p = k == 9 ? (const unsigned*)ap->out : (const unsigned*)(WS + offs[k]); const size_t n = lens[k] / 4;
        unsigned h = 0u;
        for (size_t i = (size_t)F.bx * 512 + F.tid; i < n; i += (size_t)F.G * 512) h += p[i] * (unsigned)(2 * i + 1);
        atomicAdd(CTL + CW_HASH + k, h);
    }
}
__device__ __forceinline__ void dbg_emit(Frame& F) {
    kargs_t ap = kargs(); unsigned char* WS = ap->ws; unsigned* CTL = (unsigned*)(WS + WS_CTL); float* OUT = ap->out;
    for (size_t i = (size_t)F.bx * 512 + threadIdx.x; i < (size_t)MTOK * 1024; i += (size_t)F.G * 512) {
        float v = 0.f;
        if (i < 10) { float sc = (DBG_HMASK >> i) & 1 ? 1.f : 0.f; v = sc * (1.0f + (float)(CTL[CW_HASH + i] & 0x7fffffu) * (1.0f / 8388608.0f)); }
        OUT[i] = v;
    }
}
__global__ void __launch_bounds__(NWAVES * 64, 2) mk_fwd(Args args) {
    extern __shared__ __attribute__((aligned(16))) unsigned char lds[];
    Frame F;
    F.lds = (LAS unsigned char*)lds;
    F.MISC = (volatile LAS unsigned*)(F.lds + MISC_OFF);
    F.tid = threadIdx.x; F.lane = F.tid & 63; F.wave = __builtin_amdgcn_readfirstlane(F.tid >> 6);
    F.G = gridDim.x; F.bx = blockIdx.x; { const int bx = blockIdx.x; F.vcu = (F.G % 8 == 0) ? (bx % 8) * (F.G / 8) + bx / 8 : bx; }
    for (int u = F.tid; u < (LDS_BYTES - LDSCTL_OFF) / 4; u += NWAVES * 64) ((LAS unsigned*)(F.lds + LDSCTL_OFF))[u] = 0u;
    __syncthreads();
    XcdBarrier bar; bar.bar = (unsigned*)(args.ws + WS_CTL) + CW_BAR; bar.x = 0; bar.st = nullptr;
    if (N_LAUNCHES == 1) bar = xcd_barrier_post((unsigned*)(args.ws + WS_CTL) + CW_BAR, F.MISC + 8);
#define GRID_BAR() do { if (N_LAUNCHES == 1) { bar.bar = (unsigned*)(kargs()->ws + WS_CTL) + CW_BAR; xcd_barrier(bar); } } while (0)
    const int lo = args.ph_lo, hi = args.ph_hi;
#ifndef PH_MASK
#define PH_MASK 0x7ff
#endif
#define PH(k) ((((PH_MASK) >> (k)) & 1) && lo <= (k) && (k) < hi)
#ifndef PH_DOUBLE
#define PH_DOUBLE 0
#endif
#define REP(k) for (int rep_ = 0; rep_ < 1 + (((PH_DOUBLE) >> (k)) & 1); ++rep_)
#define BOTH(k) (PH(k) && PH((k) + 1))
#define VIEWS() kargs_t ap = kargs(); inarr_t IN = (inarr_t)ap->in; unsigned char* WS = ap->ws; unsigned* CTL = (unsigned*)(WS + WS_CTL); float* OUT = ap->out; (void)IN; (void)OUT; (void)CTL; \
    bf16* Hb = (bf16*)(WS + WS_H); bf16* Zb = (bf16*)(WS + WS_Z); (void)Hb; (void)Zb
    if (PH(0)) { REP(0) ph_adaln(F); if (BOTH(0)) GRID_BAR(); }
    if (PH(1)) { REP(1) ph_prologue(F); if (BOTH(1)) GRID_BAR(); }
    if (PH(2)) {
        VIEWS();
        pg8::Gemm g{Hb, (const bf16*)(WS + WS_WIN), MTOK, ZW, 1024, 0, 0}; pg8::StaticOrder S; S.init(MTOK, ZW, F.G, F.bx);
        pg8::EpiBf16 E{Zb, ZW, nullptr, 0};
        REP(2) pg8::gemm_phase<pg8::EpiBf16, pg8::StaticOrder, false>(F.lds + RING_OFF, g, S, E);
        if (BOTH(2)) GRID_BAR();
    }
    if (PH(3)) { REP(3) ph_select(F); if (BOTH(3)) GRID_BAR(); }
    if (PH(4)) {
        VIEWS();
        const bf16* Qn = (const bf16*)(WS + WS_QN); const bf16* Kn = (const bf16*)(WS + WS_KN); bf16* YB = (bf16*)(WS + WS_YAB) + (size_t)MTOK * 512;
        REP(4) for (int v = F.vcu; v < 256; v += F.G) { const int bh = v >> 3, s = v & 7;
            attn_body::attn_unit(bh >> 3, bh & 7, 15 - s, Qn, Kn, Zb + ZC_V, ZW, YB, (const u64*)(WS + WS_MASK), (char*)lds + RING_OFF);
            attn_body::attn_unit(bh >> 3, bh & 7, s, Qn, Kn, Zb + ZC_V, ZW, YB, (const u64*)(WS + WS_MASK), (char*)lds + RING_OFF); }
        if (BOTH(4)) GRID_BAR();
    }
    if (PH(5)) {
        VIEWS();
        pg8::Gemm g{(const bf16*)(WS + WS_YAB), (const bf16*)(WS + WS_PAB), 2 * MTOK, 2048, 512, 0, 0}; MergeOrder S; S.so.init(MTOK, 1024, F.G, F.bx);
        pg8::EpiMerge E{(bf16*)(WS + WS_MRG), Zb, ZW, ZC_GA, ZC_GBR};
        REP(5) pg8::gemm_phase<pg8::EpiMerge, MergeOrder, false>(F.lds + RING_OFF, g, S, E);
        if (BOTH(5)) GRID_BAR();
    }
    if (PH(6)) {
        VIEWS();
        pg8::Gemm g{(const bf16*)(WS + WS_MRG), (const bf16*)(WS + WS_WO), MTOK, 1024, 1024, 0, 0}; pg8::StaticOrder S; S.init(MTOK, 1024, F.G, F.bx);
        pg8::EpiResid E{IN[I_X], OUT, (const float*)(CTL + CW_MOD) + 2048};
        REP(6) pg8::gemm_phase<pg8::EpiResid, pg8::StaticOrder, false>(F.lds + RING_OFF, g, S, E);
        if (BOTH(6)) GRID_BAR();
    }
    if (PH(7)) { REP(7) ph_router(F, rep_); if (BOTH(7)) GRID_BAR(); }
    if (PH(8)) {
        moe_table(F);
        VIEWS();
        MoeOrder S{(const LAS int*)(F.lds + TAB_OFF), 8, F.G, F.bx, (const int*)(WS + WS_LIST)};
        if (MOE_FP8) { pg8::Gemm g{(const bf16*)(WS + WS_H8), (const bf16*)(WS + WS_WGU), MTOK, 2048 * NEXP, 1024, ONE_E8M0, W8_SCALE_E8M0};
            pg8::EpiSwiGLU8 E{(unsigned char*)(WS + WS_ACT), IN[I_BGU]};
            REP(8) pg8::gemm_phase<pg8::EpiSwiGLU8, MoeOrder, true, true>(F.lds + RING_OFF, g, S, E); }
        else { pg8::Gemm g{Hb, (const bf16*)(WS + WS_WGU), MTOK, 2048 * NEXP, 1024, 0, 0};
            pg8::EpiSwiGLU E{(bf16*)(WS + WS_ACT), IN[I_BGU]};
            REP(8) pg8::gemm_phase<pg8::EpiSwiGLU, MoeOrder, true, false>(F.lds + RING_OFF, g, S, E); }
        if (BOTH(8)) GRID_BAR();
    }
    if (PH(9)) {
        moe_table(F);
        VIEWS();
        MoeOrder S{(const LAS int*)(F.lds + TAB_OFF), 4, F.G, F.bx, (const int*)(WS + WS_LIST)};
        pg8::EpiBf16 E{(bf16*)(WS + WS_YBUF), 1024, IN[I_BD], 1024};
        if (MOE_FP8) { pg8::Gemm g{(const bf16*)(WS + WS_ACT), (const bf16*)(WS + WS_WD), MAXSLOT, 1024 * NEXP, 1024, ONE_E8M0, W8_SCALE_E8M0};
            REP(9) pg8::gemm_phase<pg8::EpiBf16, MoeOrder, false, true>(F.lds + RING_OFF, g, S, E); }
        else { pg8::Gemm g{(const bf16*)(WS + WS_ACT), (const bf16*)(WS + WS_WD), MAXSLOT, 1024 * NEXP, 1024, 0, 0};
            REP(9) pg8::gemm_phase<pg8::EpiBf16, MoeOrder, false, false>(F.lds + RING_OFF, g, S, E); }
        if (BOTH(9)) GRID_BAR();
    }
    if (PH(10)) { REP(10) ph_combine(F, rep_ == 0 && ((PH_DOUBLE >> 10) & 1)); }
#ifdef PH_XBAR
    for (int xb_ = 0; xb_ < PH_XBAR; ++xb_) GRID_BAR();
#endif
    if (lo == 20) dbg_hash(F);
    if (lo == 21) dbg_emit(F);
#undef PH
#undef BOTH
#undef GRID_BAR
#undef VIEWS
}

extern "C" void kernel_launch(void* const* d_in, const int* in_sizes, int n_in, void* d_out, int out_size, void* d_ws, size_t ws_size, hipStream_t stream) {
    static int grid = 0;
    if (grid == 0) {
        if (n_in != 19 || in_sizes[0] != MTOK * 1024 || out_size != MTOK * 1024 || ws_size < WS_END) { fprintf(stderr, "kernel_launch: unexpected shapes / workspace (n_in %d, ws %zu < %zu)\n", n_in, ws_size, (size_t)WS_END); grid = -1; return; }
        int dev = 0, cus = 0, per_cu = 0;
        if (hipGetDevice(&dev) != hipSuccess || hipDeviceGetAttribute(&cus, hipDeviceAttributeMultiprocessorCount, dev) != hipSuccess) { grid = -1; return; }
        if (hipFuncSetAttribute((const void*)mk_fwd, hipFuncAttributeMaxDynamicSharedMemorySize, LDS_BYTES) != hipSuccess) { fprintf(stderr, "kernel_launch: hipFuncSetAttribute failed\n"); grid = -1; return; }
        if (hipOccupancyMaxActiveBlocksPerMultiprocessor(&per_cu, (const void*)mk_fwd, NWAVES * 64, LDS_BYTES) != hipSuccess || per_cu < 1) fprintf(stderr, "kernel_launch: occupancy query reports %d blocks per CU\n", per_cu);
        (void)hipGetLastError();
        grid = cus;
    }
    if (grid < 0) return;
    if (hipMemsetAsync((char*)d_ws + WS_CTL, 0, CTL_ZERO_BYTES, stream) != hipSuccess) return;
    Args a{};
    for (int i = 0; i < 19; ++i) a.in[i] = (const float*)d_in[i];
    a.out = (float*)d_out; a.ws = (unsigned char*)d_ws;
    if (N_LAUNCHES == 1) { a.ph_lo = 0; a.ph_hi = N_PHASES; hipLaunchKernelGGL(mk_fwd, dim3(grid), dim3(NWAVES * 64), LDS_BYTES, stream, a); }
    else { for (int p = 0; p < DBG_NPH; ++p) { a.ph_lo = p; a.ph_hi = p + 1; hipLaunchKernelGGL(mk_fwd, dim3(grid), dim3(NWAVES * 64), LDS_BYTES, stream, a); }
        if (DBG_NPH == 7) { a.ph_lo = 20; a.ph_hi = 21; hipLaunchKernelGGL(mk_fwd, dim3(grid), dim3(NWAVES * 64), LDS_BYTES, stream, a); a.ph_lo = 21; a.ph_hi = 22; hipLaunchKernelGGL(mk_fwd, dim3(grid), dim3(NWAVES * 64), LDS_BYTES, stream, a); }
        if (DBG_NPH == 9 || DBG_NPH == 8) { a.ph_lo = 10; a.ph_hi = 11; hipLaunchKernelGGL(mk_fwd, dim3(grid), dim3(NWAVES * 64), LDS_BYTES, stream, a); } }
}
```
